# Optimizing an MI355X kernel written in HIP

```python
import jax
import jax.numpy as jnp
from jax import lax
import numpy as np

D_MODEL = 4096
BATCH = 2
SEQ = 4096
DEPTH = 4

N_MIXERS = 2
N_ATTN_LAYERS = (DEPTH + 1) // 2
N_RET_LAYERS = DEPTH // 2

ATTN_HEAD_DIM = 64
ATTN_Q_HEADS = D_MODEL // ATTN_HEAD_DIM
ATTN_KV_HEADS = 8
ATTN_GROUP = ATTN_Q_HEADS // ATTN_KV_HEADS
Q_DIM = ATTN_Q_HEADS * ATTN_HEAD_DIM
KV_DIM = ATTN_KV_HEADS * ATTN_HEAD_DIM
ATTN_QKV_DIM = Q_DIM + 2 * KV_DIM
WINDOW = 128
BLOCK = 128
ROPE_THETA = 500000.0
ROPE_DIM = ATTN_HEAD_DIM // 4

RET_HEADS = 16
RET_KEY_DIM = D_MODEL // RET_HEADS
RET_VALUE_FACTOR = 2
RET_VAL_DIM = RET_VALUE_FACTOR * RET_KEY_DIM
RET_V_WIDTH = RET_HEADS * RET_VAL_DIM
RET_PROJ_DIM = 2 * D_MODEL + 2 * RET_V_WIDTH
RET_CHUNK = 128
RET_ROT_BASE = 10000.0
GN_EPS = 1e-6

N_EXPERTS = 32
TOP_K = 4
EXPERT_FF = 256
SWIGLU_LIMIT = 7.0
SWIGLU_ALPHA = 1.702

DEEPNORM_ALPHA = (2 * DEPTH) ** 0.25
DEEPNORM_BETA = (8 * DEPTH) ** -0.25
LN_EPS = 1e-5
N_MOD = 6
ADALN_INIT_SCALE = 0.1
MAX_POS_OFFSET = 1024

kernel_name = 'hybrid_swa_sink_retention_moe_deepnorm_adaln'


def _layer_norm(x, gain, bias):
    xf = x.astype(jnp.float32)
    mu = jnp.mean(xf, axis=-1, keepdims=True)
    var = jnp.mean(jnp.square(xf - mu), axis=-1, keepdims=True)
    y = (xf - mu) * lax.rsqrt(var + LN_EPS) * gain.astype(jnp.float32) + bias.astype(jnp.float32)
    return y.astype(x.dtype)


def _rope_partial(x, cos, sin):
    half = ROPE_DIM // 2
    x1 = x[..., :half]
    x2 = x[..., half:ROPE_DIM]
    return jnp.concatenate([x1 * cos - x2 * sin, x2 * cos + x1 * sin, x[..., ROPE_DIM:]], axis=-1)


def _rotate_interleaved(x, cos, sin):
    xr = x.reshape(x.shape[:-1] + (x.shape[-1] // 2, 2))
    x0, x1 = xr[..., 0], xr[..., 1]
    return jnp.stack([x0 * cos - x1 * sin, x1 * cos + x0 * sin], axis=-1).reshape(x.shape)


def _window_mask(n_blocks):
    qi = jnp.arange(BLOCK)[:, None]
    kj = jnp.arange(2 * BLOCK)[None, :]
    diff = qi + BLOCK - kj
    band = (diff >= 0) & (diff < WINDOW)
    has_prev = (jnp.arange(n_blocks) > 0)[:, None, None]
    return band[None] & (has_prev | (kj >= BLOCK)[None])


def _sliding_window_sink_attention(u, w_qkv, b_qkv, sinks, w_o, b_o, cos, sin):
    bsz, seq, _ = u.shape
    nb = seq // BLOCK
    qkv = u @ w_qkv + b_qkv
    q, k, v = jnp.split(qkv, [Q_DIM, Q_DIM + KV_DIM], axis=-1)
    q = _rope_partial(q.reshape(bsz, seq, ATTN_Q_HEADS, ATTN_HEAD_DIM), cos, sin)
    k = _rope_partial(k.reshape(bsz, seq, ATTN_KV_HEADS, ATTN_HEAD_DIM), cos, sin)
    q = q.reshape(bsz, nb, BLOCK, ATTN_KV_HEADS, ATTN_GROUP, ATTN_HEAD_DIM)

    def band_keys(t):
        t = t.reshape(bsz, nb, BLOCK, ATTN_KV_HEADS, ATTN_HEAD_DIM)
        prev = jnp.concatenate([jnp.zeros_like(t[:, :1]), t[:, :-1]], axis=1)
        return jnp.concatenate([prev, t], axis=2)

    kb = band_keys(k)
    vb = band_keys(v)
    s = jnp.einsum('bnqhgd,bnkhd->bnhgqk', q, kb).astype(jnp.float32) * (ATTN_HEAD_DIM ** -0.5)
    s = jnp.where(_window_mask(nb)[None, :, None, None], s, -jnp.inf)
    sink = jnp.broadcast_to(
        sinks.astype(jnp.float32).reshape(1, 1, ATTN_KV_HEADS, ATTN_GROUP, 1, 1), s.shape[:-1] + (1,))
    p = jax.nn.softmax(jnp.concatenate([s, sink], axis=-1), axis=-1)[..., :-1]
    o = jnp.einsum('bnhgqk,bnkhd->bnqhgd', p.astype(vb.dtype), vb)
    return o.reshape(bsz, seq, Q_DIM) @ w_o + b_o


def _retention(u, w_qkvg, gn_gain, w_o, cos, sin):
    bsz, seq, _ = u.shape
    nc = seq // RET_CHUNK
    C = RET_CHUNK
    proj = u @ w_qkvg
    q, k, v, g = jnp.split(proj, [D_MODEL, 2 * D_MODEL, 2 * D_MODEL + RET_V_WIDTH], axis=-1)
    q = _rotate_interleaved(q.reshape(bsz, seq, RET_HEADS, RET_KEY_DIM), cos, sin)
    k = _rotate_interleaved(k.reshape(bsz, seq, RET_HEADS, RET_KEY_DIM), cos, sin) * (RET_KEY_DIM ** -0.5)
    qc = q.reshape(bsz, nc, C, RET_HEADS, RET_KEY_DIM)
    kc = k.reshape(bsz, nc, C, RET_HEADS, RET_KEY_DIM)
    vc = v.reshape(bsz, nc, C, RET_HEADS, RET_VAL_DIM)

    log_decay = jnp.log1p(-jnp.exp2(-5.0 - jnp.arange(RET_HEADS, dtype=jnp.float32)))
    idx = jnp.arange(C, dtype=jnp.float32)
    rel = idx[:, None] - idx[None, :]
    decay_intra = jnp.where(rel >= 0, jnp.exp(jnp.maximum(rel, 0.0)[None] * log_decay[:, None, None]), 0.0)
    xi = jnp.exp((idx + 1.0)[None, :] * log_decay[:, None]).T[None, :, :, None]
    zeta = jnp.exp((C - 1.0 - idx)[None, :] * log_decay[:, None]).T[None, :, :, None]
    decay_chunk = jnp.exp(C * log_decay)[None, :, None, None]

    s = jnp.einsum('bnihd,bnjhd->bnhij', qc, kc) * decay_intra
    o_intra = jnp.einsum('bnhij,bnjhe->bnihe', s, vc)

    def step(state, inp):
        q_i, k_i, v_i = inp
        o = jnp.einsum('bihd,bhde->bihe', q_i, state) * xi
        state = decay_chunk * state + jnp.einsum('bjhd,bjhe->bhde', k_i * zeta, v_i)
        return state, o

    state0 = jnp.zeros((bsz, RET_HEADS, RET_KEY_DIM, RET_VAL_DIM), jnp.float32)
    _, o_inter = lax.scan(step, state0, (jnp.moveaxis(qc, 1, 0), jnp.moveaxis(kc, 1, 0), jnp.moveaxis(vc, 1, 0)))
    o = (o_intra + jnp.moveaxis(o_inter, 0, 1)).astype(jnp.float32).reshape(bsz, seq, RET_HEADS, RET_VAL_DIM)

    mu = jnp.mean(o, axis=-1, keepdims=True)
    var = jnp.mean(jnp.square(o - mu), axis=-1, keepdims=True)
    o = ((o - mu) * lax.rsqrt(var + GN_EPS)).reshape(bsz, seq, RET_V_WIDTH) * gn_gain.astype(jnp.float32)
    return (jax.nn.silu(g) * o.astype(u.dtype)) @ w_o


def _moe(u, router_w, router_b, w_gu, b_gu, w_down, b_down):
    bsz, seq, d = u.shape
    h = u.reshape(bsz * seq, d)
    logits = (h @ router_w).astype(jnp.float32) + router_b.astype(jnp.float32)
    top_v, top_i = lax.top_k(logits, TOP_K)
    top_w = jax.nn.softmax(top_v, axis=-1)
    combine = jnp.einsum('tk,tke->te', top_w, jax.nn.one_hot(top_i, N_EXPERTS, dtype=jnp.float32)).astype(u.dtype)
    gu = jnp.einsum('td,edf->tef', h, w_gu) + b_gu
    gate = jnp.minimum(gu[..., :EXPERT_FF], SWIGLU_LIMIT)
    up = jnp.clip(gu[..., EXPERT_FF:], -SWIGLU_LIMIT, SWIGLU_LIMIT)
    act = (up + 1.0) * gate * jax.nn.sigmoid(SWIGLU_ALPHA * gate)
    y = jnp.einsum('tef,efd->td', act * combine[:, :, None], w_down) + combine @ b_down
    return y.reshape(bsz, seq, d)


def setup_inputs(seed: int = 0) -> dict:
    key = jax.random.key(seed)
    ks = jax.random.split(key, 24)
    f32 = jnp.float32

    def nrm(k, shape, scale):
        return jax.random.normal(k, shape, f32) * scale

    x = nrm(ks[0], (BATCH, SEQ, D_MODEL), 1.0)
    c = nrm(ks[1], (BATCH, D_MODEL), 1.0)
    offsets = jax.random.randint(ks[2], (BATCH, 1), 0, MAX_POS_OFFSET, dtype=jnp.int32)
    positions = (jnp.arange(SEQ, dtype=jnp.int32)[None, :] + offsets).astype(jnp.int32)

    mod_w = nrm(ks[3], (D_MODEL, N_MOD * D_MODEL), ADALN_INIT_SCALE * D_MODEL ** -0.5)
    mod_b = nrm(ks[4], (N_MOD * D_MODEL,), 0.01)
    mod_layer = nrm(ks[5], (DEPTH, N_MOD, D_MODEL), 0.02)
    ln_gain = 1.0 + nrm(ks[6], (DEPTH, 2, D_MODEL), 0.02)
    ln_bias = nrm(ks[7], (DEPTH, 2, D_MODEL), 0.01)

    attn_col = jnp.concatenate([jnp.ones((Q_DIM + KV_DIM,), f32), jnp.full((KV_DIM,), DEEPNORM_BETA, f32)]) * D_MODEL ** -0.5
    attn_w_qkv = jax.random.normal(ks[8], (N_ATTN_LAYERS, D_MODEL, ATTN_QKV_DIM), f32) * attn_col
    attn_b_qkv = nrm(ks[9], (N_ATTN_LAYERS, ATTN_QKV_DIM), 0.01)
    attn_sinks = nrm(ks[10], (N_ATTN_LAYERS, ATTN_Q_HEADS), 1.0)
    attn_w_o = nrm(ks[11], (N_ATTN_LAYERS, Q_DIM, D_MODEL), DEEPNORM_BETA * Q_DIM ** -0.5)
    attn_b_o = nrm(ks[12], (N_ATTN_LAYERS, D_MODEL), 0.01)

    ret_col = jnp.concatenate([jnp.ones((2 * D_MODEL,), f32), jnp.full((RET_V_WIDTH,), DEEPNORM_BETA, f32),
                               jnp.ones((RET_V_WIDTH,), f32)]) * D_MODEL ** -0.5
    ret_w_qkvg = jax.random.normal(ks[13], (N_RET_LAYERS, D_MODEL, RET_PROJ_DIM), f32) * ret_col
    ret_gn_gain = 1.0 + nrm(ks[14], (N_RET_LAYERS, RET_V_WIDTH), 0.02)
    ret_w_o = nrm(ks[15], (N_RET_LAYERS, RET_V_WIDTH, D_MODEL), DEEPNORM_BETA * RET_V_WIDTH ** -0.5)

    router_w = nrm(ks[16], (DEPTH, D_MODEL, N_EXPERTS), D_MODEL ** -0.5)
    router_b = nrm(ks[17], (DEPTH, N_EXPERTS), 0.01)
    expert_w_gu = nrm(ks[18], (DEPTH, N_EXPERTS, D_MODEL, 2 * EXPERT_FF), DEEPNORM_BETA * D_MODEL ** -0.5)
    expert_b_gu = nrm(ks[19], (DEPTH, N_EXPERTS, 2 * EXPERT_FF), 0.01)
    expert_w_down = nrm(ks[20], (DEPTH, N_EXPERTS, EXPERT_FF, D_MODEL), DEEPNORM_BETA * EXPERT_FF ** -0.5)
    expert_b_down = nrm(ks[21], (DEPTH, N_EXPERTS, D_MODEL), 0.01)

    return {'x': x, 'c': c, 'positions': positions, 'mod_w': mod_w, 'mod_b': mod_b, 'mod_layer': mod_layer,
            'ln_gain': ln_gain, 'ln_bias': ln_bias, 'attn_w_qkv': attn_w_qkv, 'attn_b_qkv': attn_b_qkv,
            'attn_sinks': attn_sinks, 'attn_w_o': attn_w_o, 'attn_b_o': attn_b_o, 'ret_w_qkvg': ret_w_qkvg,
            'ret_gn_gain': ret_gn_gain, 'ret_w_o': ret_w_o, 'router_w': router_w, 'router_b': router_b,
            'expert_w_gu': expert_w_gu, 'expert_b_gu': expert_b_gu, 'expert_w_down': expert_w_down,
            'expert_b_down': expert_b_down}


def reference(x, c, positions, mod_w, mod_b, mod_layer, ln_gain, ln_bias, attn_w_qkv, attn_b_qkv, attn_sinks,
              attn_w_o, attn_b_o, ret_w_qkvg, ret_gn_gain, ret_w_o, router_w, router_b, expert_w_gu, expert_b_gu,
              expert_w_down, expert_b_down):
    bsz = x.shape[0]
    mod = (jax.nn.silu(c) @ mod_w + mod_b).reshape(bsz, N_MOD, D_MODEL)

    pos = positions.astype(jnp.float32)[..., None]
    inv_a = ROPE_THETA ** (-jnp.arange(0, ROPE_DIM, 2, dtype=jnp.float32) / ROPE_DIM)
    ang_a = pos * inv_a
    cos_a = jnp.cos(ang_a)[:, :, None, :].astype(x.dtype)
    sin_a = jnp.sin(ang_a)[:, :, None, :].astype(x.dtype)
    inv_r = RET_ROT_BASE ** (-jnp.linspace(0.0, 1.0, RET_KEY_DIM // 2, dtype=jnp.float32))
    ang_r = pos * inv_r
    cos_r = jnp.cos(ang_r)[:, :, None, :].astype(x.dtype)
    sin_r = jnp.sin(ang_r)[:, :, None, :].astype(x.dtype)

    for i in range(DEPTH):
        m = mod + mod_layer[i]
        shift_t, scale_t, gate_t, shift_f, scale_f, gate_f = [m[:, j, None, :] for j in range(N_MOD)]
        j = i // N_MIXERS

        u = x * (1.0 + scale_t) + shift_t
        if i % N_MIXERS == 0:
            y = _sliding_window_sink_attention(u, attn_w_qkv[j], attn_b_qkv[j], attn_sinks[j], attn_w_o[j],
                                               attn_b_o[j], cos_a, sin_a)
        else:
            y = _retention(u, ret_w_qkvg[j], ret_gn_gain[j], ret_w_o[j], cos_r, sin_r)
        x = _layer_norm(DEEPNORM_ALPHA * x + (1.0 + gate_t) * y, ln_gain[i, 0], ln_bias[i, 0])

        u = x * (1.0 + scale_f) + shift_f
        y = _moe(u, router_w[i], router_b[i], expert_w_gu[i], expert_b_gu[i], expert_w_down[i], expert_b_down[i])
        x = _layer_norm(DEEPNORM_ALPHA * x + (1.0 + gate_f) * y, ln_gain[i, 1], ln_bias[i, 1])
    return x
```

```cpp
#include <hip/hip_runtime.h>
#include <cstdio>
#include <cstdint>

#ifndef MK_ONE_LAUNCH
#define MK_ONE_LAUNCH 1
#endif

#define LAS __attribute__((address_space(3)))
typedef unsigned short bf16_t;
typedef short bf16x8 __attribute__((ext_vector_type(8)));
typedef short s16x4 __attribute__((ext_vector_type(4)));
typedef float f32x4 __attribute__((ext_vector_type(4)));
typedef float f32x2 __attribute__((ext_vector_type(2)));
typedef unsigned u32x4 __attribute__((ext_vector_type(4)));
typedef unsigned u32x2 __attribute__((ext_vector_type(2)));

constexpr int NB = 2, SEQ = 4096, T = NB * SEQ, D = 4096, NLAYER = 4;
constexpr int QKVN = 5120, RETN = 24576, RVW = 8192, RET_QKV = 16384;
constexpr int NEXP = 32, EFF = 256, GUW = 512, ECAP = 8192, MAXSLOT = 40960;
constexpr float ALPHA = 1.6817928305074290f;
constexpr float LN_EPS = 1e-5f, GN_EPS = 1e-6f;
constexpr float YP_SCALE = 8.0f;

constexpr size_t MiB = (size_t)1 << 20;
constexpr size_t WS_CTL = 0, CTL_BYTES = 1 * MiB;
constexpr size_t WS_MODP = 1 * MiB;
constexpr size_t WS_MODL = 8 * MiB;
constexpr size_t WS_CSA = 9 * MiB;
constexpr size_t WS_CSR = 10 * MiB;
constexpr size_t WS_BQKV = 18 * MiB;
constexpr size_t WS_TK = 19 * MiB;
constexpr size_t WS_ROWS = 20 * MiB;
constexpr size_t WS_U = 32 * MiB;
constexpr size_t WS_Z = 96 * MiB;
constexpr size_t WS_SP = WS_Z + 64 * MiB;
constexpr size_t WS_ACT = 224 * MiB;
constexpr size_t ACT_QKV = 0, ACT_O = 80 * MiB;
constexpr size_t ACT_QR = 0, ACT_KR = 64 * MiB, ACT_VV = 128 * MiB, ACT_SG = 256 * MiB, ACT_OR = 384 * MiB;
constexpr size_t ACT_H = 0, ACT_YP = 32 * MiB;
constexpr size_t WS_W = 736 * MiB;
constexpr size_t W_QKV = 0, W_OA = 80 * MiB, W_RET = 144 * MiB, W_OR = 528 * MiB, W_GU = 656 * MiB, W_DN = 1168 * MiB, W_END = 1424 * MiB;
constexpr size_t WS_XB = WS_W + W_END;
constexpr size_t WS_END = WS_XB + 64 * MiB;
constexpr int CW_BAR = 1024, CW_CNT = 8192;

constexpr int LDS_STAGE = 131072;
constexpr int LDSCTL_OFF = 149504;
constexpr int LDS_BYTES = 156672;
constexpr int LDS_GNST = LDSCTL_OFF + 3072;

typedef __bf16 bf16x2_t __attribute__((ext_vector_type(2)));
__device__ __forceinline__ unsigned cvt_pk_bf16(float lo, float hi) { const f32x2 v = {lo, hi}; return __builtin_bit_cast(unsigned, __builtin_convertvector(v, bf16x2_t)); }
typedef _Float16 h16x2_t __attribute__((ext_vector_type(2)));
__device__ __forceinline__ unsigned cvt_pk_f16(float lo, float hi) { const f32x2 v = {lo, hi}; return __builtin_bit_cast(unsigned, __builtin_convertvector(v, h16x2_t)); }
__device__ __forceinline__ float h_lo(unsigned w) { return (float)__builtin_bit_cast(h16x2_t, w)[0]; }
__device__ __forceinline__ float h_hi(unsigned w) { return (float)__builtin_bit_cast(h16x2_t, w)[1]; }
__device__ __forceinline__ float bf_lo(unsigned w) { return __uint_as_float(w << 16); }
__device__ __forceinline__ float bf_hi(unsigned w) { return __uint_as_float(w & 0xffff0000u); }
__device__ __forceinline__ float shx(float v, int mask, int lane) { return __int_as_float(__builtin_amdgcn_ds_bpermute((lane ^ mask) << 2, __float_as_int(v))); }
__device__ __forceinline__ float wave_sum(float v, int lane) {
#pragma unroll
    for (int o = 1; o < 64; o <<= 1) v += shx(v, o, lane);
    return v;
}
__device__ __forceinline__ u32x4 zero4u() { unsigned z = 0u; asm volatile("" : "+v"(z)); return (u32x4){z, z, z, z}; }
__device__ __forceinline__ f32x4 zero4() { float z = 0.f; asm volatile("" : "+v"(z)); return (f32x4){z, z, z, z}; }
__device__ __forceinline__ float fast_exp2(float x) { return __builtin_amdgcn_exp2f(x); }
__device__ __forceinline__ float fast_rcp(float x) { return __builtin_amdgcn_rcpf(x); }

#define OPAQUE_V(x) asm volatile("" : "+v"(x))
#define OPAQUE_S(x) asm volatile("" : "+s"(x))
__device__ __forceinline__ int opaque_tid(int wv) { unsigned m = ~0u; OPAQUE_S(m); int t = (wv << 6) | (int)__builtin_amdgcn_mbcnt_hi(m, __builtin_amdgcn_mbcnt_lo(m, 0u)); OPAQUE_V(t); return t; }
namespace pg8 {
constexpr int BM = 256, BK = 64, HALF = 128, HTB = HALF * BK * 2, STAGE_BYTES = 8 * HTB, NXCD = 8, WGM = 8;
__host__ __device__ __forceinline__ int lds_byte(int r, int c) { const int st = (r >> 4) * 2 + (c >> 5), rr = r & 15, cc = c & 31, ob = rr * 64 + cc * 2; return st * 1024 + (ob ^ (((ob >> 9) & 1) << 5)); }
__host__ __device__ __forceinline__ void stage_rc(int b, int& R, int& C) { const int st = b / 1024, sb = b % 1024, swz = sb ^ (((sb >> 9) & 1) << 5); R = (st >> 1) * 16 + swz / 64; C = (st & 1) * 32 + (swz % 64) / 2; }
__host__ __device__ __forceinline__ int perm32(int rho) { const int n = rho >> 4, i = rho & 15; return 8 * (i >> 2) + 4 * n + (i & 3); }

struct Unit { int pm, pn, e, rt, valid, seq; };

struct StaticOrder {
    static constexpr bool SKIP = false;
    int nM, nN, nwg, G, c; const bf16_t* A; const bf16_t* Bt; int K;
    __device__ void init(const bf16_t* A_, const bf16_t* Bt_, int M, int N, int K_, int G_, int c_) { A = A_; Bt = Bt_; K = K_; nM = M / BM; nN = N / BM; nwg = nM * nN; G = G_; c = c_; }
    __device__ __forceinline__ bool next(int i, Unit& u) const {
        const long L = (long)i * G + c; if (L >= nwg) return false;
        int wgid = (int)L; { const int q = nwg / NXCD, r = nwg % NXCD, xcd = wgid % NXCD, off = wgid / NXCD; wgid = (xcd < r ? xcd * (q + 1) : r * (q + 1) + (xcd - r) * q) + off; }
        const int nig = WGM * nN, gid = wgid / nig, fm = gid * WGM, gsz = (nM - fm) < WGM ? (nM - fm) : WGM;
        u = Unit{fm + ((wgid % nig) % gsz), (wgid % nig) / gsz, 0, 0, BM, i}; return true;
    }
    __device__ __forceinline__ const char* a_base(const Unit& u) const { return (const char*)A + (size_t)u.pm * BM * K * 2; }
    __device__ __forceinline__ const char* b_base(const Unit& u) const { return (const char*)Bt + (size_t)u.pn * BM * K * 2; }
    __device__ __forceinline__ int row_token(const Unit&, int r) const { return r; }
};

template <class Epi, class Sched, bool GATHER>
__device__ __forceinline__ void gemm_phase(LAS unsigned char* lds, const int K, const Sched& S, const Epi& E, const int wv) {
    const int tid = opaque_tid(wv), wid = __builtin_amdgcn_readfirstlane(tid >> 6), lane = tid & 63, wr = wid >> 2, wc = wid & 3, fr = lane & 15, fq = lane >> 4;
    const int nt = K / BK;
    unsigned voffB[2], cvA[2][2], nvA[2][2]; int Rr[2], Cc[2];
#pragma unroll
    for (int i = 0; i < 2; ++i) { int R, C; stage_rc(tid * 16 + i * 8192, R, C); Rr[i] = R; Cc[i] = C; const int Rb = Epi::WIDE ? (64 * (R >> 5) + 16 * ((R >> 2) & 3) + 4 * ((R >> 4) & 1) + (R & 3)) : Epi::PERM ? ((R & ~31) + perm32(R & 31)) : R;
        voffB[i] = (unsigned)(Rb * K + C) * 2u; }
    const size_t kstep = (size_t)(BK * 2);
    const size_t hstep = Epi::WIDE ? (size_t)8 * K * 2 : (size_t)HALF * K * 2;
    const unsigned ldsw = (unsigned)wid * 1024u;
    const int aoff = lds_byte(wr * 64 + fr, fq * 8), boff = lds_byte(wc * 32 + fr, fq * 8);
#define PG8_SA(b, h) (((b) * 2 + (h)) * HTB)
#define PG8_SB(b, h) ((4 + (b) * 2 + (h)) * HTB)
#define PG8_STAGE_B(bufoff, gbase) do { _Pragma("unroll") for (int _i = 0; _i < 2; ++_i) \
        __builtin_amdgcn_global_load_lds((const unsigned*)((const char*)(gbase) + voffB[_i]), (LAS unsigned*)(lds + (bufoff) + ldsw + _i * 8192), 16, 0, 0); } while (0)
#define PG8_STAGE_A(bufoff, gbase, v0, v1) do { \
        __builtin_amdgcn_global_load_lds((const unsigned*)((const char*)(gbase) + (v0)), (LAS unsigned*)(lds + (bufoff) + ldsw), 16, 0, 0); \
        __builtin_amdgcn_global_load_lds((const unsigned*)((const char*)(gbase) + (v1)), (LAS unsigned*)(lds + (bufoff) + ldsw + 8192), 16, 0, 0); } while (0)
#define PG8_LDA(dst, b, h) do { _Pragma("unroll") for (int m = 0; m < 4; ++m) _Pragma("unroll") for (int k = 0; k < 2; ++k) dst[m][k] = *(const LAS bf16x8*)(lds + PG8_SA(b, h) + aoff + m * 2048 + k * 1024); } while (0)
#define PG8_LDB(dst, b, h) do { _Pragma("unroll") for (int n = 0; n < 2; ++n) _Pragma("unroll") for (int k = 0; k < 2; ++k) dst[n][k] = *(const LAS bf16x8*)(lds + PG8_SB(b, h) + boff + n * 2048 + k * 1024); } while (0)
#define PG8_MMA(ai, bj, At, Bt) do { __builtin_amdgcn_s_setprio(1); if (Sched::SKIP) OPAQUE_S(mmask); _Pragma("unroll") for (int m = 0; m < 4; ++m) { if (!Sched::SKIP || __builtin_expect((mmask >> (4 * (ai) + m)) & 1, 1)) { _Pragma("unroll") for (int n = 0; n < 2; ++n) _Pragma("unroll") for (int k = 0; k < 2; ++k) \
        acc[ai][bj][m][n] = __builtin_amdgcn_mfma_f32_16x16x32_bf16(Bt[n][k], At[m][k], acc[ai][bj][m][n], 0, 0, 0); } } __builtin_amdgcn_s_setprio(0); } while (0)
#define PG8_WAIT_V(n) asm volatile("s_waitcnt vmcnt(" #n ")" ::: "memory")
#define PG8_WAIT_L(n) asm volatile("s_waitcnt lgkmcnt(" #n ")" ::: "memory")
#define PG8_BAR __builtin_amdgcn_s_barrier()
#define PG8_SCHED __builtin_amdgcn_sched_barrier(0)
    Unit cur, nxt; int ui = 0;
    if (!S.next(0, cur)) return;
    f32x4 acc[2][2][4][2];
    if constexpr (Epi::ACC_BIAS) { f32x4 bv0[2][2]; E.bias_load(cur, wc, fq, bv0);
#pragma unroll
        for (int a = 0; a < 2; ++a)
#pragma unroll
            for (int b = 0; b < 2; ++b)
#pragma unroll
                for (int m = 0; m < 4; ++m)
#pragma unroll
                    for (int n = 0; n < 2; ++n) acc[a][b][m][n] = bv0[b][n];
    } else {
#pragma unroll
    for (int a = 0; a < 2; ++a)
#pragma unroll
        for (int b = 0; b < 2; ++b)
#pragma unroll
            for (int m = 0; m < 4; ++m)
#pragma unroll
                for (int n = 0; n < 2; ++n) acc[a][b][m][n] = zero4();
    }
    bf16x8 At[4][2], B0[2][2], B1[2][2];
    int mmask = 255;
#define PG8_MCV(u) do { mmask = 0; _Pragma("unroll") for (int h_ = 0; h_ < 2; ++h_) { int q_ = ((u).valid - 128 * h_ - 64 * wr + 15) >> 4; q_ = q_ < 0 ? 0 : q_; q_ = q_ > 4 ? 4 : q_; mmask |= ((1 << q_) - 1) << (4 * h_); } mmask = __builtin_amdgcn_readfirstlane(mmask); } while (0)
    PG8_MCV(cur);
    const char* cA = S.a_base(cur); const char* cB = S.b_base(cur);
#pragma unroll
    for (int h = 0; h < 2; ++h)
#pragma unroll
        for (int i = 0; i < 2; ++i) { const int tok = GATHER ? S.row_token(cur, h * HALF + Rr[i]) : (h * HALF + Rr[i]); cvA[h][i] = (unsigned)(tok * K + Cc[i]) * 2u; nvA[h][i] = cvA[h][i]; }
    PG8_STAGE_B(PG8_SB(0, 0), cB); PG8_STAGE_B(PG8_SB(0, 1), cB + hstep); PG8_STAGE_A(PG8_SA(0, 0), cA, cvA[0][0], cvA[0][1]); PG8_STAGE_A(PG8_SA(0, 1), cA, cvA[1][0], cvA[1][1]);
    if (wr == 1) PG8_BAR;
    PG8_WAIT_V(2); PG8_BAR;
    PG8_STAGE_B(PG8_SB(1, 0), cB + kstep); PG8_STAGE_A(PG8_SA(1, 0), cA + kstep, cvA[0][0], cvA[0][1]); PG8_STAGE_B(PG8_SB(1, 1), cB + hstep + kstep);
    PG8_WAIT_V(6); PG8_BAR;
    for (;;) {
        const bool has_next = S.next(ui + 1, nxt);
        const char* nA = has_next ? S.a_base(nxt) : cA; const char* nB = has_next ? S.b_base(nxt) : cB;
        if (GATHER) {
#pragma unroll
            for (int h = 0; h < 2; ++h)
#pragma unroll
                for (int i = 0; i < 2; ++i) { if (has_next) { const int tok = S.row_token(nxt, h * HALF + Rr[i]); nvA[h][i] = (unsigned)(tok * K + Cc[i]) * 2u; } else nvA[h][i] = cvA[h][i]; }
        }
        for (int t = 0; t < nt; t += 2) {
            const bool last = (t == nt - 2);
            const char* a1 = cA + (size_t)(t + 1) * kstep;
            const char* a2 = last ? nA : cA + (size_t)(t + 2) * kstep; const char* b2 = last ? nB : cB + (size_t)(t + 2) * kstep;
            const char* a3 = a2 + kstep; const char* b3 = b2 + kstep;
            const unsigned w00 = (GATHER && last) ? nvA[0][0] : cvA[0][0], w01 = (GATHER && last) ? nvA[0][1] : cvA[0][1];
            const unsigned w10 = (GATHER && last) ? nvA[1][0] : cvA[1][0], w11 = (GATHER && last) ? nvA[1][1] : cvA[1][1];
            PG8_LDB(B0, 0, 0); PG8_LDB(B1, 0, 1); PG8_SCHED; PG8_LDA(At, 0, 0); PG8_STAGE_A(PG8_SA(1, 1), a1, cvA[1][0], cvA[1][1]);
            PG8_WAIT_V(8); PG8_WAIT_L(0); PG8_BAR; PG8_MMA(0, 0, At, B0); PG8_MMA(0, 1, At, B1); PG8_BAR; PG8_SCHED;
            PG8_LDA(At, 0, 1); PG8_STAGE_B(PG8_SB(0, 0), b2); PG8_STAGE_B(PG8_SB(0, 1), b2 + hstep); PG8_STAGE_A(PG8_SA(0, 0), a2, w00, w01);
            PG8_WAIT_V(8); PG8_WAIT_L(0); PG8_BAR; PG8_MMA(1, 0, At, B0); PG8_MMA(1, 1, At, B1); PG8_BAR; PG8_SCHED;
            PG8_LDB(B0, 1, 0); PG8_LDB(B1, 1, 1); PG8_SCHED; PG8_LDA(At, 1, 0); PG8_STAGE_A(PG8_SA(0, 1), a2, w10, w11);
            PG8_WAIT_V(8); PG8_WAIT_L(0); PG8_BAR; PG8_MMA(0, 0, At, B0); PG8_MMA(0, 1, At, B1); PG8_BAR; PG8_SCHED;
            PG8_LDA(At, 1, 1); PG8_STAGE_B(PG8_SB(1, 0), b3); PG8_STAGE_B(PG8_SB(1, 1), b3 + hstep); PG8_STAGE_A(PG8_SA(1, 0), a3, w00, w01);
            PG8_WAIT_V(8); PG8_WAIT_L(0); PG8_BAR; PG8_MMA(1, 0, At, B0); PG8_MMA(1, 1, At, B1); PG8_BAR; PG8_SCHED;
        }
        if (wr == 0) PG8_BAR;
        f32x4 nbv[2][2];
        if constexpr (Epi::ACC_BIAS) { E.bias_load_untracked(has_next ? nxt : cur, wc, fq, nbv); PG8_SCHED; }
        E(acc, cur, wr, wc, fr, fq);
        if constexpr (Epi::ACC_BIAS) { static_assert(Epi::NSTORE == 8, "counted wait below"); asm volatile("s_waitcnt vmcnt(6)" : "+v"(nbv[0][0]), "+v"(nbv[0][1]), "+v"(nbv[1][0]), "+v"(nbv[1][1]) :: "memory"); }
        if (!has_next) break;
#pragma unroll
        for (int a = 0; a < 2; ++a)
#pragma unroll
            for (int b = 0; b < 2; ++b)
#pragma unroll
                for (int m = 0; m < 4; ++m)
#pragma unroll
                    for (int n = 0; n < 2; ++n) { if constexpr (Epi::ACC_BIAS) acc[a][b][m][n] = nbv[b][n]; else acc[a][b][m][n] = zero4(); }
        cur = nxt; cA = nA; cB = nB; ++ui; PG8_MCV(cur);
#pragma unroll
        for (int h = 0; h < 2; ++h)
#pragma unroll
            for (int i = 0; i < 2; ++i) cvA[h][i] = nvA[h][i];
        if (wr == 1) PG8_BAR;
    }
    PG8_WAIT_V(0);
    PG8_BAR;
#undef PG8_MCV
#undef PG8_SA
#undef PG8_SB
#undef PG8_STAGE_A
#undef PG8_STAGE_B
#undef PG8_LDA
#undef PG8_LDB
#undef PG8_MMA
#undef PG8_WAIT_V
#undef PG8_WAIT_L
#undef PG8_BAR
#undef PG8_SCHED
}

struct EpiQKV {
    static constexpr bool PERM = true; static constexpr bool WIDE = false; static constexpr bool ACC_BIAS = false;
    bf16_t* O; const float* bias; const float* cosA; const float* sinA;
    __device__ __forceinline__ void operator()(const f32x4 (&acc)[2][2][4][2], const Unit& u, int wr, int wc, int fr, int fq) const {
        const int row0 = u.pm * BM + wr * 64 + fr, col0 = u.pn * BM + wc * 32 + 8 * fq;
        const bool rope = (u.pn < 18) && ((wc & 1) == 0) && (fq < 2);
        f32x4 bv[2][2];
#pragma unroll
        for (int bj = 0; bj < 2; ++bj)
#pragma unroll
            for (int n = 0; n < 2; ++n) bv[bj][n] = *(const f32x4*)(bias + col0 + bj * HALF + 4 * n);
#pragma unroll
        for (int ai = 0; ai < 2; ++ai)
#pragma unroll
            for (int m = 0; m < 4; ++m) { const int row = row0 + ai * HALF + m * 16;
                f32x4 cs = *(const f32x4*)(cosA + (size_t)row * 8 + 4 * (fq & 1)), sn = *(const f32x4*)(sinA + (size_t)row * 8 + 4 * (fq & 1));

#pragma unroll
                for (int jx = 0; jx < 4; ++jx) { cs[jx] = rope ? cs[jx] : 1.0f; sn[jx] = rope ? sn[jx] : 0.0f; }
                bf16_t* rowp = O + (size_t)row * QKVN + col0;
#pragma unroll
                for (int bj = 0; bj < 2; ++bj) { const f32x4 v0 = acc[ai][bj][m][0] + bv[bj][0], v1 = acc[ai][bj][m][1] + bv[bj][1];
                    const f32x4 o0 = v0 * cs - v1 * sn, o1 = v1 * cs + v0 * sn;
                    u32x4 w; w.x = cvt_pk_bf16(o0[0], o0[1]); w.y = cvt_pk_bf16(o0[2], o0[3]); w.z = cvt_pk_bf16(o1[0], o1[1]); w.w = cvt_pk_bf16(o1[2], o1[3]);
                    *(u32x4*)(rowp + bj * HALF) = w; } }
    }
};
struct EpiRet {
    static constexpr bool PERM = true; static constexpr bool WIDE = false; static constexpr bool ACC_BIAS = false;
    bf16_t *QR, *KR, *VV; const float* csR;
    __device__ __forceinline__ void operator()(const f32x4 (&acc)[2][2][4][2], const Unit& u, int wr, int wc, int fr, int fq) const {
        const int row0 = u.pm * BM + wr * 64 + fr, colt = wc * 32 + 8 * fq, pn = u.pn;
        if (pn < 32) {
            bf16_t* dst = pn < 16 ? QR : KR; const int hc = (pn & 15) * 256; const float sc = pn < 16 ? 1.f : 0.0625f;
#pragma unroll
            for (int ai = 0; ai < 2; ++ai)
#pragma unroll
                for (int m = 0; m < 4; ++m) { const int row = row0 + ai * HALF + m * 16;
#pragma unroll
                    for (int bj = 0; bj < 2; ++bj) { f32x4 o[2];
#pragma unroll
                        for (int n = 0; n < 2; ++n) { const int i0 = 64 * bj + 16 * wc + 4 * fq + 2 * n;
                            const f32x4 t = *(const f32x4*)(csR + ((size_t)row * 128 + i0) * 2); const f32x4 v = acc[ai][bj][m][n];
                            o[n] = (f32x4){(v[0] * t[0] - v[1] * t[1]) * sc, (v[1] * t[0] + v[0] * t[1]) * sc, (v[2] * t[2] - v[3] * t[3]) * sc, (v[3] * t[2] + v[2] * t[3]) * sc}; }
                        u32x4 w; w.x = cvt_pk_bf16(o[0][0], o[0][1]); w.y = cvt_pk_bf16(o[0][2], o[0][3]); w.z = cvt_pk_bf16(o[1][0], o[1][1]); w.w = cvt_pk_bf16(o[1][2], o[1][3]);
                        *(u32x4*)(dst + (size_t)row * D + hc + bj * HALF + colt) = w; } }
        } else {
            bf16_t* dst = VV; const int hc = (pn - 32) * 256;
#pragma unroll
            for (int ai = 0; ai < 2; ++ai)
#pragma unroll
                for (int m = 0; m < 4; ++m) { const int row = row0 + ai * HALF + m * 16;
#pragma unroll
                    for (int bj = 0; bj < 2; ++bj) { f32x4 o[2];
#pragma unroll
                        for (int n = 0; n < 2; ++n) o[n] = acc[ai][bj][m][n];
                        u32x4 w; w.x = cvt_pk_bf16(o[0][0], o[0][1]); w.y = cvt_pk_bf16(o[0][2], o[0][3]); w.z = cvt_pk_bf16(o[1][0], o[1][1]); w.w = cvt_pk_bf16(o[1][2], o[1][3]);
                        *(u32x4*)(dst + (size_t)row * RVW + hc + bj * HALF + colt) = w; } }
        }
    }
};
struct EpiG {
    static constexpr bool PERM = true; static constexpr bool WIDE = false; static constexpr bool ACC_BIAS = false;
    bf16_t* OR; const float* SP; const float* gng; LAS float* st; bf16_t* OW;
    __device__ __forceinline__ void operator()(const f32x4 (&acc)[2][2][4][2], const Unit& u, int wr, int wc, int fr, int fq) const {
        const int tid = (wr * 4 + wc) * 64 + fq * 16 + fr, h = u.pn >> 1; LAS float* sb = st + (u.seq & 1) * 512;
        const int row0 = u.pm * BM + wr * 64 + fr, col0 = u.pn * BM + wc * 32 + 8 * fq;
        u32x4 ob[2][2];
#pragma unroll
        for (int m = 0; m < 2; ++m)
#pragma unroll
            for (int bj = 0; bj < 2; ++bj) ob[m][bj] = *(const u32x4*)(OR + (size_t)(row0 + m * 16) * RVW + col0 + bj * HALF);
        f32x4 gv[2][2];
#pragma unroll
        for (int bj = 0; bj < 2; ++bj)
#pragma unroll
            for (int n = 0; n < 2; ++n) gv[bj][n] = *(const f32x4*)(gng + col0 + bj * HALF + 4 * n);
        if (tid < 256) { const float* p = SP + ((size_t)(u.pm * BM + tid) * 16 + h) * 16; float s1 = 0.f, s2 = 0.f;
#pragma unroll
            for (int k = 0; k < 4; ++k) { const f32x4 t = *(const f32x4*)(p + 4 * k); s1 += t[0] + t[2]; s2 += t[1] + t[3]; }
            const float mean = s1 * (1.0f / 512.0f), var = fmaxf(s2 * (1.0f / 512.0f) - mean * mean, 0.f);
            sb[2 * tid] = mean; sb[2 * tid + 1] = 1.0f / sqrtf(var + GN_EPS); }
        asm volatile("s_waitcnt lgkmcnt(0)" ::: "memory"); __builtin_amdgcn_s_barrier(); asm volatile("" ::: "memory");
#pragma unroll
        for (int am = 0; am < 4; ++am) { const int ai = am >> 1, m0 = 2 * (am & 1); u32x4 oc[2][2];
#pragma unroll
            for (int m = 0; m < 2; ++m)
#pragma unroll
                for (int bj = 0; bj < 2; ++bj) oc[m][bj] = ob[m][bj];
            if (am < 3) { const int an = am + 1, ain = an >> 1, mn = 2 * (an & 1);
#pragma unroll
                for (int m = 0; m < 2; ++m)
#pragma unroll
                    for (int bj = 0; bj < 2; ++bj) ob[m][bj] = *(const u32x4*)(OR + (size_t)(row0 + ain * HALF + (mn + m) * 16) * RVW + col0 + bj * HALF); }
#pragma unroll
            for (int mm = 0; mm < 2; ++mm) { const int m = m0 + mm; const int r = ai * HALF + wr * 64 + m * 16 + fr; const float mean = sb[2 * r], rstd = sb[2 * r + 1];
                const size_t roff = (size_t)(row0 + ai * HALF + m * 16) * RVW + col0;
#pragma unroll
                for (int bj = 0; bj < 2; ++bj) { const u32x4 ov = oc[mm][bj];
                    const float ox[8] = {bf_lo(ov.x), bf_hi(ov.x), bf_lo(ov.y), bf_hi(ov.y), bf_lo(ov.z), bf_hi(ov.z), bf_lo(ov.w), bf_hi(ov.w)}; float a2[8];
#pragma unroll
                    for (int n = 0; n < 2; ++n)
#pragma unroll
                        for (int jx = 0; jx < 4; ++jx) { const float g = acc[ai][bj][m][n][jx]; const float sg = g * fast_rcp(1.f + fast_exp2(-1.4426950408889634f * g));
                            a2[4 * n + jx] = sg * ((ox[4 * n + jx] - mean) * rstd * gv[bj][n][jx]); }
                    u32x4 w; w.x = cvt_pk_bf16(a2[0], a2[1]); w.y = cvt_pk_bf16(a2[2], a2[3]); w.z = cvt_pk_bf16(a2[4], a2[5]); w.w = cvt_pk_bf16(a2[6], a2[7]);
                    *(u32x4*)(OW + roff + bj * HALF) = w; } } }
    }
};
struct EpiZ {
    static constexpr bool PERM = true; static constexpr bool WIDE = false; static constexpr bool ACC_BIAS = false;
    bf16_t* Y; const float* bias; const float* gate;
    __device__ __forceinline__ void operator()(const f32x4 (&acc)[2][2][4][2], const Unit& u, int wr, int wc, int fr, int fq) const {
        const int row0 = u.pm * BM + wr * 64 + fr, col0 = u.pn * BM + wc * 32 + 8 * fq; const float* gp = gate + (size_t)(u.pm >> 4) * 6 * D;
        f32x4 bv[2][2], gv[2][2];
#pragma unroll
        for (int bj = 0; bj < 2; ++bj)
#pragma unroll
            for (int n = 0; n < 2; ++n) { if (bias) bv[bj][n] = *(const f32x4*)(bias + col0 + bj * HALF + 4 * n); else bv[bj][n] = zero4(); gv[bj][n] = *(const f32x4*)(gp + col0 + bj * HALF + 4 * n) + 1.0f; }
#pragma unroll
        for (int ai = 0; ai < 2; ++ai)
#pragma unroll
            for (int m = 0; m < 4; ++m) { bf16_t* rowp = Y + (size_t)(row0 + ai * HALF + m * 16) * D + col0;
#pragma unroll
                for (int bj = 0; bj < 2; ++bj) { const f32x4 v0 = gv[bj][0] * (acc[ai][bj][m][0] + bv[bj][0]), v1 = gv[bj][1] * (acc[ai][bj][m][1] + bv[bj][1]);
                    u32x4 w; w.x = cvt_pk_bf16(v0[0], v0[1]); w.y = cvt_pk_bf16(v0[2], v0[3]); w.z = cvt_pk_bf16(v1[0], v1[1]); w.w = cvt_pk_bf16(v1[2], v1[3]);
                    *(u32x4*)(rowp + bj * HALF) = w; } }
    }
};
struct EpiGU {
    static constexpr bool PERM = true; static constexpr bool WIDE = false; static constexpr bool ACC_BIAS = false;
    bf16_t* H; const float* bgu;
    __device__ __forceinline__ void operator()(const f32x4 (&acc)[2][2][4][2], const Unit& u, int wr, int wc, int fr, int fq) const {
        const int row0 = u.pm * BM + wr * 64 + fr, fcol = u.pn * 128 + wc * 32 + 8 * fq; const float* bp = bgu + u.e * GUW;
        f32x4 bg[2], bu[2];
#pragma unroll
        for (int n = 0; n < 2; ++n) { bg[n] = *(const f32x4*)(bp + fcol + 4 * n); bu[n] = *(const f32x4*)(bp + EFF + fcol + 4 * n); }
#pragma unroll
        for (int ai = 0; ai < 2; ++ai)
#pragma unroll
            for (int m = 0; m < 4; ++m) { const int row = row0 + ai * HALF + m * 16; float o[8];
#pragma unroll
                for (int n = 0; n < 2; ++n) { const f32x4 g4 = acc[ai][0][m][n] + bg[n], u4 = acc[ai][1][m][n] + bu[n];
#pragma unroll
                    for (int j = 0; j < 4; ++j) { const float g = fminf(g4[j], 7.0f), up = fminf(fmaxf(u4[j], -7.0f), 7.0f);
                        o[4 * n + j] = (up + 1.0f) * g * fast_rcp(1.0f + fast_exp2(-1.702f * 1.4426950408889634f * g)); } }
                u32x4 w; w.x = cvt_pk_bf16(o[0], o[1]); w.y = cvt_pk_bf16(o[2], o[3]); w.z = cvt_pk_bf16(o[4], o[5]); w.w = cvt_pk_bf16(o[6], o[7]);
                *(u32x4*)(H + (size_t)row * EFF + fcol) = w; }
    }
};
struct EpiDown {
    static constexpr bool PERM = true; static constexpr bool WIDE = true; static constexpr bool ACC_BIAS = true;
    unsigned char* Y; const float* bdn;
    __device__ __forceinline__ void bias_load(const Unit& u, int wc, int fq, f32x4 (&bv)[2][2]) const {
        const float* bp = bdn + (size_t)u.e * D + u.pn * BM + wc * 64 + 16 * fq;
#pragma unroll
        for (int bj = 0; bj < 2; ++bj)
#pragma unroll
            for (int n = 0; n < 2; ++n) bv[bj][n] = *(const f32x4*)(bp + 8 * bj + 4 * n);
    }
    __device__ __forceinline__ void bias_load_untracked(const Unit& u, int wc, int fq, f32x4 (&bv)[2][2]) const {
        const float* bp = bdn + (size_t)u.e * D + u.pn * BM + wc * 64 + 16 * fq;
        asm volatile("global_load_dwordx4 %0, %4, off\n\tglobal_load_dwordx4 %1, %4, off offset:16\n\tglobal_load_dwordx4 %2, %4, off offset:32\n\tglobal_load_dwordx4 %3, %4, off offset:48"
                     : "=&v"(bv[0][0]), "=&v"(bv[0][1]), "=&v"(bv[1][0]), "=&v"(bv[1][1]) : "v"(bp) : "memory");
    }
    static constexpr int NSTORE = 8;
    __device__ __forceinline__ void operator()(const f32x4 (&acc)[2][2][4][2], const Unit& u, int wr, int wc, int fr, int fq) const {
        const int row0 = u.pm * BM + wr * 64 + fr, col0 = u.pn * BM + wc * 64 + 16 * fq;
#pragma unroll
        for (int ai = 0; ai < 2; ++ai)
#pragma unroll
            for (int m = 0; m < 4; ++m) { unsigned char* rowp = Y + (size_t)(row0 + ai * HALF + m * 16) * D + col0;
                int w[4];
#pragma unroll
                for (int bj = 0; bj < 2; ++bj) { f32x4 v0 = acc[ai][bj][m][0] * YP_SCALE, v1 = acc[ai][bj][m][1] * YP_SCALE;
#pragma unroll
                    for (int jx = 0; jx < 4; ++jx) { v0[jx] = __builtin_amdgcn_fmed3f(v0[jx], -448.0f, 448.0f); v1[jx] = __builtin_amdgcn_fmed3f(v1[jx], -448.0f, 448.0f); }
                    int w0 = 0, w1 = 0; w0 = __builtin_amdgcn_cvt_pk_fp8_f32(v0[0], v0[1], w0, false); w0 = __builtin_amdgcn_cvt_pk_fp8_f32(v0[2], v0[3], w0, true);
                    w1 = __builtin_amdgcn_cvt_pk_fp8_f32(v1[0], v1[1], w1, false); w1 = __builtin_amdgcn_cvt_pk_fp8_f32(v1[2], v1[3], w1, true);
                    w[2 * bj] = w0; w[2 * bj + 1] = w1; }
                *(u32x4*)rowp = (u32x4){(unsigned)w[0], (unsigned)w[1], (unsigned)w[2], (unsigned)w[3]}; }
    }
};
struct GuOrder {
    static constexpr bool SKIP = true;
    int G, c, L0, L1; const LAS int* ts; const LAS int* cn; const int* rows; const bf16_t* U; const bf16_t* W;
    __device__ __forceinline__ bool next(int i, Unit& u) const {
        const int L = L0 + i * G + c; if (L >= L1) return false;
        const int tg = (__builtin_amdgcn_readfirstlane(ts[480 + (L >> 1)]) >> 20) & 255, e = __builtin_amdgcn_readfirstlane(ts[480 + tg]) & 255, rt = tg - __builtin_amdgcn_readfirstlane(ts[e]);
        const int left = __builtin_amdgcn_readfirstlane(cn[e]) - rt * BM;
        u = Unit{tg, L & 1, e, rt, left < BM ? left : BM, i}; return true;
    }
    __device__ __forceinline__ const char* a_base(const Unit&) const { return (const char*)U; }
    __device__ __forceinline__ const char* b_base(const Unit& u) const { return (const char*)W + ((size_t)(u.e * GUW + u.pn * BM)) * D * 2; }
    __device__ __forceinline__ int row_token(const Unit& u, int r) const { return rows[u.e * ECAP + (r < u.valid ? u.rt * BM + r : 0)]; }
};
struct DownOrder {
    static constexpr bool SKIP = true;
    int G, c, D0, D1, nlate; const LAS int* ts; const LAS int* cn; const bf16_t* Hb; const bf16_t* W;
    static constexpr int PRE = 7;
    __device__ __forceinline__ bool next(int i, Unit& u) const {
        const int NL = G - nlate; int L;
        if (c < nlate) L = D0 + PRE * NL + i * G + c;
        else L = D0 + (i < PRE ? i * NL + (c - nlate) : PRE * NL + (i - PRE) * G + c);
        if (nlate == 0) L = D0 + i * G + c;
        if (L >= D1) return false;
        const int tg = (__builtin_amdgcn_readfirstlane(ts[480 + (L >> 4)]) >> 20) & 255, e = __builtin_amdgcn_readfirstlane(ts[480 + tg]) & 255, rt = tg - __builtin_amdgcn_readfirstlane(ts[e]);
        const int left = __builtin_amdgcn_readfirstlane(cn[e]) - rt * BM;
        u = Unit{tg, L & 15, e, rt, left < BM ? left : BM, i}; return true;
    }
    __device__ __forceinline__ const char* a_base(const Unit& u) const { return (const char*)Hb + (size_t)u.pm * BM * EFF * 2; }
    __device__ __forceinline__ const char* b_base(const Unit& u) const { return (const char*)W + ((size_t)u.e * D + u.pn * BM) * EFF * 2; }
    __device__ __forceinline__ int row_token(const Unit&, int r) const { return r; }
};
}

#define XB_TMO      128
#define XB_XCNT(j)  (256  + 64 * (j))
#define XB_XSUB(j)  (1280 + 64 * (j))
#define XB_XGEN(j)  (2304 + 64 * (j))
#define XB_TOP      3328
#define XB_TOPGEN   3392
#define XCD_BAR_WORDS 3456
#define XB_SPIN_CAP (1u << 18)
__device__ __forceinline__ unsigned xb_ld(unsigned* p)              { return __hip_atomic_load(p, __ATOMIC_RELAXED, __HIP_MEMORY_SCOPE_AGENT); }
__device__ __forceinline__ unsigned xb_add(unsigned* p, unsigned v) { return __hip_atomic_fetch_add(p, v, __ATOMIC_RELAXED, __HIP_MEMORY_SCOPE_AGENT); }
__device__ __forceinline__ unsigned xb_xcc_id() { return (unsigned)__builtin_amdgcn_s_getreg((3 << 11) | 20) & 0xFu; }
#define XB_SPIN(cond, bar) do { unsigned _sp = 0; while (cond) { __builtin_amdgcn_s_sleep(1); \
    if ((++_sp & 255u) == 0u) { if (xb_ld(&(bar)[XB_TMO])) break; if (_sp > XB_SPIN_CAP) { atomicAdd(&(bar)[XB_TMO], 1u); break; } } } } while (0)
struct XcdBarrier { unsigned* bar; unsigned x; volatile LAS unsigned* st; };
__device__ __forceinline__ XcdBarrier xcd_barrier_post(unsigned* bar, volatile LAS unsigned* st) {
    XcdBarrier b; b.bar = bar; b.x = xb_xcc_id(); b.st = st;
    if (threadIdx.x == 0) (void)xb_add(&bar[XB_XCNT(b.x)], 1u);
    return b;
}
__device__ __forceinline__ void xcd_barrier_complete(unsigned* bar, unsigned x, unsigned& nloc, unsigned& nx) {
    const unsigned G = gridDim.x * gridDim.y * gridDim.z;
    unsigned sum, cnt, mine, sp = 0u;
    for (;;) {
        sum = 0u; cnt = 0u; mine = 0u;
#pragma unroll
        for (unsigned j = 0; j < 16; ++j) { const unsigned c = xb_ld(&bar[XB_XCNT(j)]); sum += c; cnt += (c > 0u) ? 1u : 0u; mine = (j == x) ? c : mine; }
        if (sum == G) break;
        __builtin_amdgcn_s_sleep(1);
        if ((++sp & 255u) == 0u) { if (xb_ld(&bar[XB_TMO])) break; if (sp > XB_SPIN_CAP) { atomicAdd(&bar[XB_TMO], 1u); break; } }
    }
    nloc = mine > 0u ? mine : 1u; nx = cnt > 0u ? cnt : 1u;
}
__device__ __forceinline__ void xcd_barrier(const XcdBarrier& b, const int tid) {
    asm volatile("s_waitcnt vmcnt(0)" ::: "memory");
    __syncthreads();
    if (tid == 0) {
        unsigned* bar = b.bar;
        __builtin_amdgcn_s_waitcnt(0);
        unsigned nloc = b.st[0], nx = b.st[1];
        if (nloc == 0u) { xcd_barrier_complete(bar, b.x, nloc, nx); b.st[0] = nloc; b.st[1] = nx; }
        const unsigned old = xb_add(&bar[XB_XSUB(b.x)], 1u);
        const unsigned gen = old / nloc;
        if (old + 1u == (gen + 1u) * nloc) {
            __builtin_amdgcn_fence(__ATOMIC_RELEASE, "agent");
            asm volatile("s_waitcnt vmcnt(0)" ::: "memory");
            const unsigned og = xb_add(&bar[XB_TOP], 1u);
            const unsigned tg = og / nx;
            if (og + 1u == (tg + 1u) * nx) xb_add(&bar[XB_TOPGEN], 1u);
            else XB_SPIN(xb_ld(&bar[XB_TOPGEN]) == tg, bar);
            __builtin_amdgcn_fence(__ATOMIC_ACQUIRE, "agent");
            xb_add(&bar[XB_XGEN(b.x)], 1u);
            asm volatile("s_waitcnt vmcnt(0)" ::: "memory");
        } else {
            XB_SPIN(xb_ld(&bar[XB_XGEN(b.x)]) == gen, bar);
            __builtin_amdgcn_fence(__ATOMIC_ACQUIRE, "agent");
            asm volatile("s_waitcnt vmcnt(0)" ::: "memory");
        }
    }
    __syncthreads();
}

struct Args {
    const float* x; const float* c; const int* pos; const float* mod_w; const float* mod_b; const float* mod_layer; const float* ln_gain; const float* ln_bias;
    const float* w_qkv; const float* b_qkv; const float* sinks; const float* w_oa; const float* b_oa; const float* w_ret; const float* gn_gain; const float* w_or;
    const float* router_w; const float* router_b; const float* w_gu; const float* b_gu; const float* w_dn; const float* b_dn;
    float* out; unsigned char* ws; int ph_lo, ph_hi, use_bar, k_dn;
};
typedef const __attribute__((address_space(4))) Args CArgs;

__device__ __forceinline__ void transpose_item(const float* W, int K, int N, bf16_t* WT, int kb, int n0s, int n0d, bool rp, LAS float* scr, int lane) {
    const int k0 = 64 * kb;
    f32x4 tv[8];
#pragma unroll
    for (int i = 0; i < 8; ++i) tv[i] = __builtin_nontemporal_load((const f32x4*)(W + (size_t)(k0 + 8 * i + (lane >> 3)) * N + n0s + 4 * (lane & 7)));
#pragma unroll
    for (int i = 0; i < 8; ++i) { LAS float* d = scr + (8 * i + (lane >> 3)) * 33 + 4 * (lane & 7); d[0] = tv[i][0]; d[1] = tv[i][1]; d[2] = tv[i][2]; d[3] = tv[i][3]; }
    asm volatile("s_waitcnt lgkmcnt(0)" ::: "memory");
    const int cch = lane & 7;
#pragma unroll
    for (int j = 0; j < 4; ++j) { const int n = (lane >> 3) + 8 * j; int ns = n;
        if (rp && n < 16) ns = (n & 3) | ((n & 4) << 1) | ((n & 8) >> 1);
        const LAS float* s = scr + (8 * cch) * 33 + ns;
        u32x4 o; o.x = cvt_pk_bf16(s[0 * 33], s[1 * 33]); o.y = cvt_pk_bf16(s[2 * 33], s[3 * 33]); o.z = cvt_pk_bf16(s[4 * 33], s[5 * 33]); o.w = cvt_pk_bf16(s[6 * 33], s[7 * 33]);
        __builtin_nontemporal_store(o, (u32x4*)(WT + (size_t)(n0d + n) * K + k0 + 8 * cch)); }
    asm volatile("s_waitcnt lgkmcnt(0)" ::: "memory");
}
__device__ __forceinline__ float silu_f(float v) { return v / (1.0f + __expf(-v)); }

__device__ __forceinline__ void prep_items(CArgs& a, LAS unsigned char* lds, int wave, int lane, int worker, int nworkers, int mode) {
    bf16_t* Wb = (bf16_t*)(a.ws + WS_W);
    LAS float* scr = (LAS float*)(lds + wave * 16384);
    constexpr int I_QKV = 64 * 160, I_OA = 64 * 128, I_RET = 64 * 768, I_OR = 128 * 128, I_GU = 64 * 16, I_DN = 4 * 128;
    constexpr int E_QKV = 2 * I_QKV, E_OA = E_QKV + 2 * I_OA, E_RET = E_OA + 2 * I_RET, E_OR = E_RET + 2 * I_OR, E_GU = E_OR + 128 * I_GU, E_DN = E_GU + 128 * I_DN;
    constexpr int SIDE = 8192;
    const int nq = mode == 0 ? E_DN : SIDE;
    for (int q0 = worker; q0 < nq; q0 += nworkers) {
        int it = q0;
        if (mode == 0) { if ((it >= E_QKV + I_OA && it < E_QKV + I_OA + SIDE) || (it >= E_RET + I_OR && it < E_RET + I_OR + SIDE)) continue; }
        else if (mode == 1) it = E_QKV + I_OA + q0;
        else it = E_RET + I_OR + q0;
        if (it < E_QKV) { const int j = it / I_QKV, r = it % I_QKV, kb = r / 160, nb = r % 160; const int n0 = 32 * nb;
            transpose_item(a.w_qkv + (size_t)j * D * QKVN, D, QKVN, Wb + (W_QKV / 2) + (size_t)j * QKVN * D, kb, n0, n0, (n0 < 4608) && ((n0 & 63) == 0), scr, lane); }
        else if (it < E_OA) { const int q = it - E_QKV, j = q / I_OA, r = q % I_OA, kb = r / 128, nb = r % 128;
            transpose_item(a.w_oa + (size_t)j * D * D, D, D, Wb + (W_OA / 2) + (size_t)j * D * D, kb, 32 * nb, 32 * nb, false, scr, lane); }
        else if (it < E_RET) { const int q = it - E_OA, j = q / I_RET, r = q % I_RET, kb = r / 768, nb = r % 768;
            transpose_item(a.w_ret + (size_t)j * D * RETN, D, RETN, Wb + (W_RET / 2) + (size_t)j * RETN * D, kb, 32 * nb, 32 * nb, false, scr, lane); }
        else if (it < E_OR) { const int q = it - E_RET, j = q / I_OR, r = q % I_OR, kb = r / 128, nb = r % 128;
            transpose_item(a.w_or + (size_t)j * RVW * D, RVW, D, Wb + (W_OR / 2) + (size_t)j * D * RVW, kb, 32 * nb, 32 * nb, false, scr, lane); }
        else if (it < E_GU) { const int q = it - E_OR, mi = q / I_GU, r = q % I_GU, kb = r / 16, nb = r % 16;
            const int rowd = 32 * nb, tt = rowd >> 8, p = rowd & 255, bj = p >> 7, qq = p & 127; const int cols = bj * 256 + tt * 128 + qq;
            transpose_item(a.w_gu + (size_t)mi * D * GUW, D, GUW, Wb + (W_GU / 2) + (size_t)mi * GUW * D, kb, cols, rowd, false, scr, lane); }
        else { const int q = it - E_GU, mi = q / I_DN, r = q % I_DN, kb = r / 128, nb = r % 128;
            transpose_item(a.w_dn + (size_t)mi * EFF * D, EFF, D, Wb + (W_DN / 2) + (size_t)mi * D * EFF, kb, 32 * nb, 32 * nb, false, scr, lane); }
    }
}

__device__ __forceinline__ void phase_prep(CArgs& a, LAS unsigned char* lds, int G, int c, int wv) {
    const int tid = opaque_tid(wv), lane = tid & 63, wave = __builtin_amdgcn_readfirstlane(tid >> 6);
    const int gw = c * 8 + wave, NGW = G * 8;
    unsigned char* ws = a.ws;
    { float* modp = (float*)(ws + WS_MODP);
      for (int task = gw; task < 96 * 32; task += NGW) { const int cg = task % 96, kp = task / 96; const int col = cg * 256 + 4 * lane;
          f32x4 a0 = zero4(), a1 = zero4();
#pragma unroll 8
          for (int kk = 0; kk < 128; ++kk) { const int k = kp * 128 + kk; const f32x4 w = *(const f32x4*)(a.mod_w + (size_t)k * 24576 + col);
              const float s0 = silu_f(a.c[k]), s1 = silu_f(a.c[D + k]); a0 += w * s0; a1 += w * s1; }
          *(f32x4*)(modp + ((size_t)kp * 2 + 0) * 24576 + col) = a0; *(f32x4*)(modp + ((size_t)kp * 2 + 1) * 24576 + col) = a1; } }
    { const int gt = gw * 64 + lane, NT = NGW * 64;
      float* cosA = (float*)(ws + WS_CSA); float* sinA = cosA + T * 8; float* csR = (float*)(ws + WS_CSR); float* bq = (float*)(ws + WS_BQKV);
      for (int i = gt; i < T * 8; i += NT) { const int tok = i >> 3, f = i & 7; const float inv = powf(500000.0f, -(float)(2 * f) / 16.0f); const float ang = (float)a.pos[tok] * inv; cosA[i] = cosf(ang); sinA[i] = sinf(ang); }
      for (int i = gt; i < T * 128; i += NT) { const int tok = i >> 7, f = i & 127; const float inv = powf(10000.0f, -((float)f / 127.0f)); const float ang = (float)a.pos[tok] * inv; csR[2 * (size_t)i] = cosf(ang); csR[2 * (size_t)i + 1] = sinf(ang); }
      for (int i = gt; i < 2 * QKVN; i += NT) { const int j = i / QKVN, n = i % QKVN; int ns = n; const int p = n & 63;
          if (n < 4608 && p < 16) ns = (n & ~15) | (p & 3) | ((p & 4) << 1) | ((p & 8) >> 1);
          bq[i] = a.b_qkv[j * QKVN + ns]; } }
    prep_items(a, lds, wave, lane, gw, NGW, 0);
}
__device__ __forceinline__ void phase_modreduce(CArgs& a, int G, int c, int wv) {
    const float* modp = (const float*)(a.ws + WS_MODP); float* modL = (float*)(a.ws + WS_MODL);
    const int tid = opaque_tid(wv);
    for (int o = c * 512 + tid; o < 2 * 24576; o += G * 512) { const int b = o / 24576, col = o % 24576; float s = a.mod_b[col];
        for (int kp = 0; kp < 32; ++kp) s += modp[((size_t)kp * 2 + b) * 24576 + col];
#pragma unroll
        for (int l = 0; l < NLAYER; ++l) modL[((size_t)l * 2 + b) * 24576 + col] = s + a.mod_layer[(size_t)l * 24576 + col]; }
}
__device__ __forceinline__ void store_u_row(const f32x4 (&xv)[16], const float* shift, const float* scale, bf16_t* urow, int lane) {
#pragma unroll
    for (int jj = 0; jj < 16; ++jj) { const int col = 256 * jj + 4 * lane; const f32x4 sc = *(const f32x4*)(scale + col) + 1.0f, sh = *(const f32x4*)(shift + col);
        const f32x4 u = xv[jj] * sc + sh; u32x2 w; w.x = cvt_pk_bf16(u[0], u[1]); w.y = cvt_pk_bf16(u[2], u[3]); *(u32x2*)(urow + col) = w; }
}
__device__ __forceinline__ void phase_u0(CArgs& a, LAS unsigned char* lds, int G, int c, int wv) {
    const int tid = opaque_tid(wv), lane = tid & 63, wave = __builtin_amdgcn_readfirstlane(tid >> 6); const float* modL = (const float*)(a.ws + WS_MODL); bf16_t* U = (bf16_t*)(a.ws + WS_U);
    LAS float* TL = (LAS float*)lds;
    { f32x4 tvv[8];
#pragma unroll
      for (int i = 0; i < 8; ++i) { const int t = i >> 1, col = (i & 1) * 2048 + tid * 4; tvv[i] = (t < 2) ? *(const f32x4*)(modL + (size_t)t * 24576 + col) : *(const f32x4*)(modL + (size_t)(t - 2) * 24576 + D + col); }
#pragma unroll
      for (int i = 0; i < 8; ++i) { const int t = i >> 1, col = (i & 1) * 2048 + tid * 4; *(LAS f32x4*)(TL + t * D + col) = (t < 2) ? tvv[i] : tvv[i] + 1.0f; } }
    __syncthreads();
    for (int row = c * 8 + wave; row < T; row += G * 8) { const int b = row >> 12;
        f32x4 xv[16];
#pragma unroll
        for (int jj = 0; jj < 16; ++jj) xv[jj] = *(const f32x4*)(a.x + (size_t)row * D + 256 * jj + 4 * lane);
        unsigned so = (unsigned)(uintptr_t)(TL + b * D), co = (unsigned)(uintptr_t)(TL + (2 + b) * D); OPAQUE_S(so); OPAQUE_S(co);
        const LAS float* sp = (const LAS float*)(uintptr_t)so; const LAS float* cp = (const LAS float*)(uintptr_t)co; bf16_t* urow = U + (size_t)row * D;
#pragma unroll
        for (int jj = 0; jj < 16; ++jj) { const int col = 256 * jj + 4 * lane; const f32x4 u = xv[jj] * *(const LAS f32x4*)(cp + col) + *(const LAS f32x4*)(sp + col);
            u32x2 w; w.x = cvt_pk_bf16(u[0], u[1]); w.y = cvt_pk_bf16(u[2], u[3]); *(u32x2*)(urow + col) = w;
            u32x2 xh; xh.x = cvt_pk_f16(xv[jj][0], xv[jj][1]); xh.y = cvt_pk_f16(xv[jj][2], xv[jj][3]); __builtin_nontemporal_store(xh, (u32x2*)((bf16_t*)(a.ws + WS_XB) + (size_t)row * D + col)); } }
}
template <bool C8> __device__ __forceinline__ int lncol(int jj, int lane) { return C8 ? 512 * (jj >> 1) + 8 * lane + 4 * (jj & 1) : 256 * jj + 4 * lane; }
template <bool C8 = false>
__device__ __forceinline__ void ln_row(f32x4 (&v)[16], const float* gain, const float* bias, int lane) {
    float s = 0.f;
#pragma unroll
    for (int jj = 0; jj < 16; ++jj) s += (v[jj][0] + v[jj][1]) + (v[jj][2] + v[jj][3]);
    const float mean = wave_sum(s, lane) * (1.0f / D); float q = 0.f;
#pragma unroll
    for (int jj = 0; jj < 16; ++jj) { v[jj] = v[jj] - mean; q += (v[jj][0] * v[jj][0] + v[jj][1] * v[jj][1]) + (v[jj][2] * v[jj][2] + v[jj][3] * v[jj][3]); }
    const float rstd = 1.0f / sqrtf(wave_sum(q, lane) * (1.0f / D) + LN_EPS);
#pragma unroll
    for (int jj = 0; jj < 16; ++jj) { const int col = lncol<C8>(jj, lane); v[jj] = v[jj] * rstd * *(const f32x4*)(gain + col) + *(const f32x4*)(bias + col); }
}
template <bool C8 = false>
__device__ __forceinline__ void ln_row_lds(f32x4 (&v)[16], const LAS float* gain, const LAS float* bias, int lane) {
    unsigned go = (unsigned)(uintptr_t)gain, bo = (unsigned)(uintptr_t)bias; OPAQUE_S(go); OPAQUE_S(bo);
    const LAS float* gp = (const LAS float*)(uintptr_t)go; const LAS float* bp = (const LAS float*)(uintptr_t)bo;
    float s = 0.f;
#pragma unroll
    for (int jj = 0; jj < 16; ++jj) s += (v[jj][0] + v[jj][1]) + (v[jj][2] + v[jj][3]);
    const float mean = wave_sum(s, lane) * (1.0f / D); float q = 0.f;
#pragma unroll
    for (int jj = 0; jj < 16; ++jj) { v[jj] = v[jj] - mean; q += (v[jj][0] * v[jj][0] + v[jj][1] * v[jj][1]) + (v[jj][2] * v[jj][2] + v[jj][3] * v[jj][3]); }
    const float rstd = 1.0f / sqrtf(wave_sum(q, lane) * (1.0f / D) + LN_EPS);
#pragma unroll
    for (int jj = 0; jj < 16; ++jj) { const int col = lncol<C8>(jj, lane); v[jj] = v[jj] * rstd * *(const LAS f32x4*)(gp + col) + *(const LAS f32x4*)(bp + col); }
}
__device__ __forceinline__ void phase_ln1(CArgs& a, LAS unsigned char* lds, int layer, int G, int c, int wv, bool dry) {
    const bf16_t* Xb = (const bf16_t*)(a.ws + WS_XB); bf16_t* Xw = (bf16_t*)(a.ws + WS_XB);
    const int tid = opaque_tid(wv), lane = tid & 63, wave = __builtin_amdgcn_readfirstlane(tid >> 6);
    const bf16_t* Yp = (const bf16_t*)(a.ws + WS_Z); bf16_t* U = (bf16_t*)(a.ws + WS_U); const float* modL = (const float*)(a.ws + WS_MODL) + (size_t)layer * 2 * 24576;
    const float* gain = a.ln_gain + ((size_t)layer * 2 + 0) * D; const float* bias = a.ln_bias + ((size_t)layer * 2 + 0) * D;
    const float* rw = a.router_w + (size_t)layer * D * NEXP; const float* rb = a.router_b + layer * NEXP;
    unsigned* cnt = (unsigned*)(a.ws + WS_CTL) + CW_CNT + layer * 64;
    int* rows = (int*)(a.ws + WS_ROWS); int* tk_e = (int*)(a.ws + WS_TK); int* tk_pos = tk_e + T * 4; float* tk_w = (float*)(tk_pos + T * 4);
    constexpr int UP = 4352;
    LAS float* uL = (LAS float*)lds;
    LAS float* pL = (LAS float*)(lds + 8 * UP * 4);
    LAS float* lg = (LAS float*)(lds + 8 * UP * 4 + 8192);
    const float rbv = rb[tid & 31];
    u32x4 yq[8], xq[8];
    { const int row = c * 8 + wave;
#pragma unroll
      for (int p = 0; p < 8; ++p) yq[p] = __builtin_nontemporal_load((const u32x4*)(Yp + (size_t)row * D + 512 * p + 8 * lane));
#pragma unroll
      for (int p = 0; p < 8; ++p) xq[p] = __builtin_nontemporal_load((const u32x4*)(Xb + (size_t)row * D + 512 * p + 8 * lane)); }
    for (int it = c; it < T / 8; it += G) {
        const int row = it * 8 + wave, b = row >> 12; const float* mb = modL + (size_t)b * 24576;
        f32x4 v[16];
        f32x4 tA[16], tB[16];
        typedef const __attribute__((address_space(1))) float* gfp_t; typedef const __attribute__((address_space(1))) f32x4* gf4p_t;
        typedef const __attribute__((address_space(1))) char* gcp_t; const unsigned tvo = 32u * (unsigned)lane;
        gcp_t tgp = (gcp_t)gain, tbp = (gcp_t)bias, tcp = (gcp_t)(mb + 4 * D), thp = (gcp_t)(mb + 3 * D);
#define LN1_TLOAD(t, hb) { gcp_t g_ = tgp + 4096 * (hb), b_ = tbp + 4096 * (hb), c_ = tcp + 4096 * (hb), h_ = thp + 4096 * (hb); OPAQUE_S(g_); OPAQUE_S(b_); OPAQUE_S(c_); OPAQUE_S(h_); \
            _Pragma("unroll") for (int q = 0; q < 4; ++q) { const int off = 2048 * (q >> 1) + 16 * (q & 1); \
            t[q] = *(gf4p_t)(g_ + (size_t)tvo + off); t[4 + q] = *(gf4p_t)(b_ + (size_t)tvo + off); t[8 + q] = *(gf4p_t)(c_ + (size_t)tvo + off); t[12 + q] = *(gf4p_t)(h_ + (size_t)tvo + off); } }
#define LN1_TUSE(t, hb) { _Pragma("unroll") for (int pp = 0; pp < 2; ++pp) { const int p = 2 * (hb) + pp, col = 512 * p + 8 * lane; \
            const f32x4 x0 = v[2 * p] * rstd * t[2 * pp] + t[4 + 2 * pp], x1 = v[2 * p + 1] * rstd * t[2 * pp + 1] + t[4 + 2 * pp + 1]; \
            u32x4 wx; wx.x = cvt_pk_f16(x0[0], x0[1]); wx.y = cvt_pk_f16(x0[2], x0[3]); wx.z = cvt_pk_f16(x1[0], x1[1]); wx.w = cvt_pk_f16(x1[2], x1[3]); \
            *(u32x4*)((dry ? (bf16_t*)(a.ws + WS_ACT + ACT_SG) : Xw) + (size_t)row * D + col) = wx; \
            const f32x4 u0 = x0 * (t[8 + 2 * pp] + 1.0f) + t[12 + 2 * pp], u1 = x1 * (t[8 + 2 * pp + 1] + 1.0f) + t[12 + 2 * pp + 1]; \
            u32x4 w; w.x = cvt_pk_bf16(u0[0], u0[1]); w.y = cvt_pk_bf16(u0[2], u0[3]); w.z = cvt_pk_bf16(u1[0], u1[1]); w.w = cvt_pk_bf16(u1[2], u1[3]); *(u32x4*)(U + (size_t)row * D + col) = w; \
            *(LAS f32x4*)(uL + wave * UP + col + 4 * (col >> 6)) = u0; *(LAS f32x4*)(uL + wave * UP + col + 4 + 4 * (col >> 6)) = u1; } }
        LN1_TLOAD(tA, 0)
        __builtin_amdgcn_sched_barrier(0);
#pragma unroll
        for (int p = 0; p < 8; ++p) { v[2 * p] = (f32x4){h_lo(xq[p].x), h_hi(xq[p].x), h_lo(xq[p].y), h_hi(xq[p].y)}; v[2 * p + 1] = (f32x4){h_lo(xq[p].z), h_hi(xq[p].z), h_lo(xq[p].w), h_hi(xq[p].w)}; }
#pragma unroll
        for (int p = 0; p < 8; ++p) { v[2 * p] = v[2 * p] * ALPHA + (f32x4){bf_lo(yq[p].x), bf_hi(yq[p].x), bf_lo(yq[p].y), bf_hi(yq[p].y)}; v[2 * p + 1] = v[2 * p + 1] * ALPHA + (f32x4){bf_lo(yq[p].z), bf_hi(yq[p].z), bf_lo(yq[p].w), bf_hi(yq[p].w)}; }
        __builtin_amdgcn_sched_barrier(0); LN1_TLOAD(tB, 1) __builtin_amdgcn_sched_barrier(0);
        float rstd; { float s_ = 0.f;
#pragma unroll
            for (int jj = 0; jj < 16; ++jj) s_ += (v[jj][0] + v[jj][1]) + (v[jj][2] + v[jj][3]);
            const float mean = wave_sum(s_, lane) * (1.0f / D); float q_ = 0.f;
#pragma unroll
            for (int jj = 0; jj < 16; ++jj) { v[jj] = v[jj] - mean; q_ += (v[jj][0] * v[jj][0] + v[jj][1] * v[jj][1]) + (v[jj][2] * v[jj][2] + v[jj][3] * v[jj][3]); }
            rstd = 1.0f / sqrtf(wave_sum(q_, lane) * (1.0f / D) + LN_EPS); }
        const int eg = tid & 7, ks = tid >> 3; gcp_t wp = (gcp_t)rw; f32x4 wA[8], wB[8]; const unsigned wvo = (unsigned)((ks * 64 * NEXP + 4 * eg) * 4);
        gcp_t wph = wp + 32 * NEXP * 4; OPAQUE_S(wp); OPAQUE_S(wph);
#define LN1_WLOAD(w, g) { _Pragma("unroll") for (int i = 0; i < 8; ++i) w[i] = *(gf4p_t)(((g) < 4 ? wp : wph) + (size_t)wvo + (8 * ((g) & 3) + i) * NEXP * 4); }
        __builtin_amdgcn_sched_barrier(0);
        LN1_TUSE(tA, 0) __builtin_amdgcn_sched_barrier(0);
        LN1_TLOAD(tA, 2) __builtin_amdgcn_sched_barrier(0); LN1_TUSE(tB, 1) __builtin_amdgcn_sched_barrier(0);
        LN1_TLOAD(tB, 3) __builtin_amdgcn_sched_barrier(0); LN1_TUSE(tA, 2) __builtin_amdgcn_sched_barrier(0);
        LN1_WLOAD(wA, 0) __builtin_amdgcn_sched_barrier(0); LN1_TUSE(tB, 3) __builtin_amdgcn_sched_barrier(0);
        __syncthreads();
        { f32x4 acc[8];
#pragma unroll
          for (int r = 0; r < 8; ++r) acc[r] = zero4();
          const LAS float* up = uL + ks * 68;
#define LN1_WUSE(w, g) { _Pragma("unroll") for (int s4 = 0; s4 < 2; ++s4) { _Pragma("unroll") for (int r = 0; r < 8; ++r) { const f32x4 uv = *(const LAS f32x4*)(up + r * UP + 8 * (g) + 4 * s4); \
              acc[r] = w[4 * s4 + 0] * uv[0] + acc[r]; acc[r] = w[4 * s4 + 1] * uv[1] + acc[r]; acc[r] = w[4 * s4 + 2] * uv[2] + acc[r]; acc[r] = w[4 * s4 + 3] * uv[3] + acc[r]; } } }
          LN1_WLOAD(wB, 1) __builtin_amdgcn_sched_barrier(0); LN1_WUSE(wA, 0) __builtin_amdgcn_sched_barrier(0);
          LN1_WLOAD(wA, 2) __builtin_amdgcn_sched_barrier(0); LN1_WUSE(wB, 1) __builtin_amdgcn_sched_barrier(0);
          LN1_WLOAD(wB, 3) __builtin_amdgcn_sched_barrier(0); LN1_WUSE(wA, 2) __builtin_amdgcn_sched_barrier(0);
          LN1_WLOAD(wA, 4) __builtin_amdgcn_sched_barrier(0); LN1_WUSE(wB, 3) __builtin_amdgcn_sched_barrier(0);
          LN1_WLOAD(wB, 5) __builtin_amdgcn_sched_barrier(0); LN1_WUSE(wA, 4) __builtin_amdgcn_sched_barrier(0);
          LN1_WLOAD(wA, 6) __builtin_amdgcn_sched_barrier(0); LN1_WUSE(wB, 5) __builtin_amdgcn_sched_barrier(0);
          LN1_WLOAD(wB, 7) __builtin_amdgcn_sched_barrier(0); LN1_WUSE(wA, 6) __builtin_amdgcn_sched_barrier(0);
          LN1_WUSE(wB, 7)
#pragma unroll
          for (int r = 0; r < 8; ++r)
#pragma unroll
              for (int jx = 0; jx < 4; ++jx) { float t = acc[r][jx]; t += shx(t, 8, lane); t += shx(t, 16, lane); t += shx(t, 32, lane); acc[r][jx] = t; }
          if (lane < 8) {
#pragma unroll
              for (int r = 0; r < 8; ++r) *(LAS f32x4*)(pL + (wave * 8 + r) * NEXP + 4 * eg) = acc[r]; } }
        { const int itn = it + G < T / 8 ? it + G : it, rown = itn * 8 + wave;
#pragma unroll
            for (int p = 0; p < 8; ++p) yq[p] = __builtin_nontemporal_load((const u32x4*)(Yp + (size_t)rown * D + 512 * p + 8 * lane));
#pragma unroll
            for (int p = 0; p < 8; ++p) xq[p] = __builtin_nontemporal_load((const u32x4*)(Xb + (size_t)rown * D + 512 * p + 8 * lane)); }
        __syncthreads();
        if (tid < 256) { const int r = tid >> 5, e = tid & 31; float s = rbv;
#pragma unroll
            for (int wq = 0; wq < 8; ++wq) s += pL[(wq * 8 + r) * NEXP + e];
            lg[r * NEXP + e] = s; }
        __syncthreads();
        if (!dry) {
            const int tok = it * 8 + wave; float val = lg[wave * NEXP + (lane & 31)]; float tv = 0.f, t0 = 0.f; int te = 0;
#pragma unroll
            for (int k = 0; k < 4; ++k) { float bv = val; int bi = lane & 31;
#pragma unroll
                for (int o = 1; o < 32; o <<= 1) { const float ov = shx(bv, o, lane); const int oi = __builtin_amdgcn_ds_bpermute((lane ^ o) << 2, bi); if (ov > bv || (ov == bv && oi < bi)) { bv = ov; bi = oi; } }
                if (k == 0) t0 = bv; if (lane == k) { tv = bv; te = bi; } if ((lane & 31) == bi) val = -3.0e38f; }
            float ex = (lane < 4) ? __expf(tv - t0) : 0.f; float den = ex; den += shx(den, 1, lane); den += shx(den, 2, lane);
            if (lane < 4) { const unsigned p = atomicAdd(cnt + te, 1u); rows[te * ECAP + (int)p] = tok; tk_e[tok * 4 + lane] = te; tk_pos[tok * 4 + lane] = (int)p; tk_w[tok * 4 + lane] = ex / den; } }
        __syncthreads();
    }
}
__device__ __forceinline__ int moe_tables(CArgs& a, LAS unsigned char* lds, int layer, int wv, bool reuse) {
    LAS int* ts = (LAS int*)(lds + LDSCTL_OFF); LAS int* cn = ts + 64;
    if (reuse) return ts[NEXP];
    const unsigned* cnt = (const unsigned*)(a.ws + WS_CTL) + CW_CNT + layer * 64;
    const int tid = opaque_tid(wv);
    __syncthreads();
    if (tid < NEXP) cn[tid] = (int)__hip_atomic_load(cnt + tid, __ATOMIC_RELAXED, __HIP_MEMORY_SCOPE_AGENT);
    __syncthreads();
    if (tid == 0) { int acc = 0; for (int e = 0; e < NEXP; ++e) { ts[e] = acc; acc += (cn[e] + 255) >> 8; } ts[NEXP] = acc; }
    __syncthreads();
    const int ntile = ts[NEXP];
    if (tid < MAXSLOT / 256) { int e = 0;
#pragma clang loop vectorize(disable)
        for (int k = 0; k < NEXP; ++k) if (tid >= ts[k + 1]) e = k + 1;
        e = e < NEXP ? e : NEXP - 1; int left = cn[e] - (tid - ts[e]) * 256; left = left < 256 ? left : 256; if (tid >= ntile) left = 0;
        ts[480 + tid] = e | (left << 8); }
    __syncthreads();
    int rank = 0;
    if (tid < ntile) { const int mine = (ts[480 + tid] >> 8) & 511;
#pragma unroll 1
        for (int j0 = 0; j0 < MAXSLOT / 256; j0 += 16) { int vv[16];
#pragma unroll
            for (int j = 0; j < 16; ++j) vv[j] = ts[480 + j0 + j];
#pragma unroll
            for (int j = 0; j < 16; ++j) { const int vj = (vv[j] >> 8) & 511; rank += (vj > mine || (vj == mine && j0 + j < tid)) ? 1 : 0; } } }
    __syncthreads();
    if (tid < ntile) ts[480 + rank] |= tid << 20;
    __syncthreads();
    return ntile;
}
__device__ __forceinline__ void phase_ln2(CArgs& a, LAS unsigned char* lds, int layer, int G, int c, int wv, bool dry, bool reuse_tab) {
    const int tid = opaque_tid(wv), lane = tid & 63, wave = __builtin_amdgcn_readfirstlane(tid >> 6);
    (void)moe_tables(a, lds, layer, wv, reuse_tab);
    const LAS int* ts = (const LAS int*)(lds + LDSCTL_OFF);
    const unsigned char* YP = (const unsigned char*)(a.ws + WS_ACT + ACT_YP); bf16_t* U = (bf16_t*)(a.ws + WS_U);
    const float* modL = (const float*)(a.ws + WS_MODL) + (size_t)layer * 2 * 24576; const float* modN = (const float*)(a.ws + WS_MODL) + (size_t)(layer + 1) * 2 * 24576;
    const float* gain = a.ln_gain + ((size_t)layer * 2 + 1) * D; const float* bias = a.ln_bias + ((size_t)layer * 2 + 1) * D; const bf16_t* Xb = (const bf16_t*)(a.ws + WS_XB);
    const int* tk_e = (const int*)(a.ws + WS_TK); const int* tk_pos = tk_e + T * 4; const float* tk_w = (const float*)(tk_pos + T * 4);
    LAS float* TL = (LAS float*)lds;
    { f32x4 tvv[16]; const bool hn = layer + 1 < NLAYER;
#pragma unroll
      for (int i = 0; i < 16; ++i) { const int t = i >> 1, col = (i & 1) * 2048 + tid * 4; const float* src;
          if (t == 0) src = gain + col; else if (t == 1) src = bias + col; else if (t < 4) src = modL + (size_t)(t - 2) * 24576 + 5 * D + col;
          else if (t < 6) src = (hn ? modN : modL) + (size_t)(t - 4) * 24576 + 0 * D + col; else src = (hn ? modN : modL) + (size_t)(t - 6) * 24576 + 1 * D + col;
          tvv[i] = *(const f32x4*)src; }
#pragma unroll
      for (int i = 0; i < 16; ++i) { const int t = i >> 1, col = (i & 1) * 2048 + tid * 4; f32x4 val = tvv[i];
          if (t == 2 || t == 3 || t >= 6) val = val + 1.0f;
          *(LAS f32x4*)(TL + t * D + col) = val; } }
    __syncthreads();
    int4 te4n, tp4n; f32x4 tw4n;
    { const int row0 = c * 8 + wave; if (row0 < T) { te4n = *(const int4*)(tk_e + row0 * 4); tp4n = *(const int4*)(tk_pos + row0 * 4); tw4n = *(const f32x4*)(tk_w + row0 * 4); } }
    for (int row = c * 8 + wave; row < T; row += G * 8) { const int b = row >> 12;
        f32x4 v[16];
        const int4 te4 = te4n, tp4 = tp4n; const f32x4 tw4 = tw4n;
        { const int rn = row + G * 8; if (rn < T) { te4n = *(const int4*)(tk_e + rn * 4); tp4n = *(const int4*)(tk_pos + rn * 4); tw4n = *(const f32x4*)(tk_w + rn * 4); } }
        const int tes[4] = {te4.x, te4.y, te4.z, te4.w}, tps[4] = {tp4.x, tp4.y, tp4.z, tp4.w};
        u32x2 yv[4][8];
#pragma unroll
        for (int k = 0; k < 4; ++k) { const unsigned char* yr = YP + ((size_t)ts[tes[k]] * 256 + tps[k]) * D + 8 * lane;
#pragma unroll
            for (int p = 0; p < 8; ++p) yv[k][p] = __builtin_nontemporal_load((const u32x2*)(yr + 512 * p)); }
        u32x4 xqa[8];
#pragma unroll
        for (int p = 0; p < 8; ++p) xqa[p] = __builtin_nontemporal_load((const u32x4*)(Xb + (size_t)row * D + 512 * p + 8 * lane));
        __builtin_amdgcn_sched_barrier(0);
        const f32x4 tws = tw4 * (1.0f / YP_SCALE);
#pragma unroll
        for (int p = 0; p < 8; ++p) { f32x4 t0 = zero4(), t1 = t0;
#pragma unroll
            for (int k = 0; k < 4; ++k) { const f32x2 a0 = __builtin_amdgcn_cvt_pk_f32_fp8((int)yv[k][p].x, false), a1 = __builtin_amdgcn_cvt_pk_f32_fp8((int)yv[k][p].x, true), b0 = __builtin_amdgcn_cvt_pk_f32_fp8((int)yv[k][p].y, false), b1 = __builtin_amdgcn_cvt_pk_f32_fp8((int)yv[k][p].y, true);
                t0 += (f32x4){a0[0], a0[1], a1[0], a1[1]} * tws[k]; t1 += (f32x4){b0[0], b0[1], b1[0], b1[1]} * tws[k]; }
            v[2 * p] = t0; v[2 * p + 1] = t1; }
        { unsigned go = (unsigned)(uintptr_t)(TL + (2 + b) * D); OPAQUE_S(go); const LAS float* gp = (const LAS float*)(uintptr_t)go;
#pragma unroll
          for (int p = 0; p < 8; ++p) { const u32x4 xq = xqa[p];
              v[2 * p] = (f32x4){h_lo(xq.x), h_hi(xq.x), h_lo(xq.y), h_hi(xq.y)} * ALPHA + *(const LAS f32x4*)(gp + 512 * p + 8 * lane) * v[2 * p];
              v[2 * p + 1] = (f32x4){h_lo(xq.z), h_hi(xq.z), h_lo(xq.w), h_hi(xq.w)} * ALPHA + *(const LAS f32x4*)(gp + 512 * p + 8 * lane + 4) * v[2 * p + 1]; } }
        ln_row_lds<true>(v, TL, TL + D, lane);
        if (layer + 1 == NLAYER) { float* xo = dry ? (float*)(a.ws + WS_Z) : a.out;
#pragma unroll
            for (int jj = 0; jj < 16; ++jj) __builtin_nontemporal_store(v[jj], (f32x4*)(xo + (size_t)row * D + lncol<true>(jj, lane))); }
        else { bf16_t* xo = dry ? (bf16_t*)(a.ws + WS_Z) : (bf16_t*)(a.ws + WS_XB);
#pragma unroll
            for (int p = 0; p < 8; ++p) { u32x4 w; w.x = cvt_pk_f16(v[2 * p][0], v[2 * p][1]); w.y = cvt_pk_f16(v[2 * p][2], v[2 * p][3]); w.z = cvt_pk_f16(v[2 * p + 1][0], v[2 * p + 1][1]); w.w = cvt_pk_f16(v[2 * p + 1][2], v[2 * p + 1][3]);
                *(u32x4*)(xo + (size_t)row * D + 512 * p + 8 * lane) = w; } }
        if (layer + 1 < NLAYER) { unsigned so = (unsigned)(uintptr_t)(TL + (4 + b) * D), co = (unsigned)(uintptr_t)(TL + (6 + b) * D); OPAQUE_S(so); OPAQUE_S(co);
            const LAS float* sp = (const LAS float*)(uintptr_t)so; const LAS float* cp = (const LAS float*)(uintptr_t)co; bf16_t* urow = U + (size_t)row * D;
#pragma unroll
            for (int p = 0; p < 8; ++p) { const int col = 512 * p + 8 * lane; const f32x4 u0 = v[2 * p] * *(const LAS f32x4*)(cp + col) + *(const LAS f32x4*)(sp + col), u1 = v[2 * p + 1] * *(const LAS f32x4*)(cp + col + 4) + *(const LAS f32x4*)(sp + col + 4);
                u32x4 w; w.x = cvt_pk_bf16(u0[0], u0[1]); w.y = cvt_pk_bf16(u0[2], u0[3]); w.z = cvt_pk_bf16(u1[0], u1[1]); w.w = cvt_pk_bf16(u1[2], u1[3]); *(u32x4*)(urow + col) = w; } }
    }
}

template <int O0, int O1>
__device__ __forceinline__ void tr_read8(unsigned base, s16x4 (&lo)[4], s16x4 (&hi)[4]) {
    asm volatile("ds_read_b64_tr_b16 %0, %8 offset:%9\n\tds_read_b64_tr_b16 %1, %8 offset:%10\n\tds_read_b64_tr_b16 %2, %8 offset:%11\n\tds_read_b64_tr_b16 %3, %8 offset:%12\n\t"
                 "ds_read_b64_tr_b16 %4, %8 offset:%13\n\tds_read_b64_tr_b16 %5, %8 offset:%14\n\tds_read_b64_tr_b16 %6, %8 offset:%15\n\tds_read_b64_tr_b16 %7, %8 offset:%16\n\ts_waitcnt lgkmcnt(0)"
                 : "=&v"(lo[0]), "=&v"(lo[1]), "=&v"(lo[2]), "=&v"(lo[3]), "=&v"(hi[0]), "=&v"(hi[1]), "=&v"(hi[2]), "=&v"(hi[3])
                 : "v"(base), "n"(O0), "n"(O0 + 32), "n"(O0 + 64), "n"(O0 + 96), "n"(O1), "n"(O1 + 32), "n"(O1 + 64), "n"(O1 + 96) : "memory");
}
template <int O0, int O1>
__device__ __forceinline__ void tr_read2(unsigned base, s16x4& lo, s16x4& hi) {
    asm volatile("ds_read_b64_tr_b16 %0, %2 offset:%3\n\tds_read_b64_tr_b16 %1, %2 offset:%4\n\ts_waitcnt lgkmcnt(0)" : "=&v"(lo), "=&v"(hi) : "v"(base), "n"(O0), "n"(O1) : "memory");
}
__device__ __forceinline__ bf16x8 cat4(s16x4 lo, s16x4 hi) { return __builtin_shufflevector(lo, hi, 0, 1, 2, 3, 4, 5, 6, 7); }

__device__ __forceinline__ void phase_attn(CArgs& a, LAS unsigned char* lds, int j, int G, int c, int wv) {
    const int tid = opaque_tid(wv), lane = tid & 63, wave = __builtin_amdgcn_readfirstlane(tid >> 6), fr = lane & 15, fq = lane >> 4, q4 = (lane & 15) >> 2, p4 = lane & 3;
    const bf16_t* QKV = (const bf16_t*)(a.ws + WS_ACT + ACT_QKV); bf16_t* O = (bf16_t*)(a.ws + WS_ACT + ACT_O);
    LAS unsigned char* Kl = lds; LAS unsigned char* Vl = lds + 256 * 144;
    const unsigned vbase = (unsigned)(uintptr_t)Vl;
    constexpr float SC = 0.125f * 1.4426950408889634f;
    for (int u = c; u < 512; u += G) {
        const int b = u >> 8, n = (u >> 3) & 31, kvh = u & 7;
        __syncthreads();
        { u32x4 kb4[4], vb4[4];
#pragma unroll
          for (int i = 0; i < 4; ++i) { const int id = tid + 512 * i, row = id >> 3, ch = id & 7, pos = n * 128 - 128 + row;
              const bf16_t* src = QKV + (size_t)(b * SEQ + (pos >= 0 ? pos : 0)) * QKVN + 4096 + kvh * 64 + ch * 8; kb4[i] = *(const u32x4*)src; vb4[i] = *(const u32x4*)(src + 512); }
#pragma unroll
          for (int i = 0; i < 4; ++i) { const int id = tid + 512 * i, row = id >> 3, ch = id & 7, pos = n * 128 - 128 + row;
              const u32x4 z = zero4u(); *(LAS u32x4*)(Kl + row * 144 + ch * 16) = pos >= 0 ? kb4[i] : z; *(LAS u32x4*)(Vl + row * 144 + ch * 16) = pos >= 0 ? vb4[i] : z; } }
        __syncthreads();
        const int hq = kvh * 8 + wave; const float sink2 = a.sinks[j * 64 + hq] * 1.4426950408889634f;
        bf16x8 qn[2];
#pragma unroll
        for (int ks = 0; ks < 2; ++ks) qn[ks] = *(const bf16x8*)(QKV + (size_t)(b * SEQ + n * 128 + fr) * QKVN + hq * 64 + 32 * ks + 8 * fq);
        for (int r = 0; r < 8; ++r) {
            const int tok = b * SEQ + n * 128 + 16 * r + fr;
            bf16x8 qf[2];
#pragma unroll
            for (int ks = 0; ks < 2; ++ks) qf[ks] = qn[ks];
            if (r < 7) {
#pragma unroll
                for (int ks = 0; ks < 2; ++ks) qn[ks] = *(const bf16x8*)(QKV + (size_t)(tok + 16) * QKVN + hq * 64 + 32 * ks + 8 * fq); }
            f32x4 st[9];
#pragma unroll
            for (int kk = 0; kk < 9; ++kk) { f32x4 acc = zero4();
#pragma unroll
                for (int ks = 0; ks < 2; ++ks) { const bf16x8 kf = *(const LAS bf16x8*)(Kl + (16 * (r + kk) + fr) * 144 + (32 * ks + 8 * fq) * 2); acc = __builtin_amdgcn_mfma_f32_16x16x32_bf16(kf, qf[ks], acc, 0, 0, 0); }
                st[kk] = acc; }
            float mx = sink2;
#pragma unroll
            for (int kk = 0; kk < 9; ++kk)
#pragma unroll
                for (int ii = 0; ii < 4; ++ii) { const int jj = 4 * fq + ii; bool vis = true;
                    if (kk == 0) vis = jj > fr; if (kk == 8) vis = jj <= fr; if (n == 0 && (r + kk) < 8) vis = false;
                    const float tv = vis ? st[kk][ii] * SC : -1.0e30f; st[kk][ii] = tv; mx = fmaxf(mx, tv); }
            mx = fmaxf(mx, shx(mx, 16, lane)); mx = fmaxf(mx, shx(mx, 32, lane));
            float l = 0.f;
#pragma unroll
            for (int kk = 0; kk < 9; ++kk)
#pragma unroll
                for (int ii = 0; ii < 4; ++ii) { const float p = fast_exp2(st[kk][ii] - mx); st[kk][ii] = p; l += p; }
            l += shx(l, 16, lane); l += shx(l, 32, lane); l += fast_exp2(sink2 - mx);
            const float inv = 1.0f / l;
            f32x4 oacc[4];
            const unsigned vrow = vbase + (16 * r + 4 * fq + q4) * 144 + 8 * p4;
#pragma unroll
            for (int cc = 0; cc < 4; ++cc) oacc[cc] = zero4();
#define ATT_PV(S, K0, K1, HASK1) { u32x4 pw; pw.x = cvt_pk_bf16(st[K0][0], st[K0][1]); pw.y = cvt_pk_bf16(st[K0][2], st[K0][3]); \
                if (HASK1) { pw.z = cvt_pk_bf16(st[K1][0], st[K1][1]); pw.w = cvt_pk_bf16(st[K1][2], st[K1][3]); } else { pw.z = 0u; pw.w = 0u; } \
                const bf16x8 pf = __builtin_bit_cast(bf16x8, pw); s16x4 lo[4], hi[4]; \
                tr_read8<16 * 144 * (K0), 16 * 144 * (K1)>(vrow, lo, hi); \
                _Pragma("unroll") for (int cc = 0; cc < 4; ++cc) oacc[cc] = __builtin_amdgcn_mfma_f32_16x16x32_bf16(cat4(lo[cc], hi[cc]), pf, oacc[cc], 0, 0, 0); }
            ATT_PV(0, 0, 1, true) ATT_PV(1, 2, 3, true) ATT_PV(2, 4, 5, true) ATT_PV(3, 6, 7, true) ATT_PV(4, 8, 8, false)
#undef ATT_PV
#pragma unroll
            for (int cc = 0; cc < 4; ++cc) { const f32x4 o = oacc[cc] * inv; u32x2 w; w.x = cvt_pk_bf16(o[0], o[1]); w.y = cvt_pk_bf16(o[2], o[3]);
                *(u32x2*)(O + (size_t)tok * D + hq * 64 + 16 * cc + 4 * fq) = w; }
        }
    }
}

__device__ __forceinline__ void phase_ret(CArgs& a, LAS unsigned char* lds, int G, int c, int wv) {
    const int tid = opaque_tid(wv), lane = tid & 63, w = __builtin_amdgcn_readfirstlane(tid >> 6), fr = lane & 15, fq = lane >> 4, q4 = (lane & 15) >> 2, p4 = lane & 3;
    const bf16_t* QR = (const bf16_t*)(a.ws + WS_ACT + ACT_QR); const bf16_t* KR = (const bf16_t*)(a.ws + WS_ACT + ACT_KR); const bf16_t* VV = (const bf16_t*)(a.ws + WS_ACT + ACT_VV);
    bf16_t* OR = (bf16_t*)(a.ws + WS_ACT + ACT_OR); float* SPp = (float*)(a.ws + WS_SP);
    constexpr int KP = 528, VP = 144;
    LAS unsigned char* Kl = lds; LAS unsigned char* Vl = lds + 128 * KP; LAS unsigned char* Vzl = Vl + 128 * VP; LAS unsigned char* Rl = Vzl + 128 * VP;
    const unsigned vb0 = (unsigned)(uintptr_t)Vl + (4 * fq + q4) * VP + 8 * p4;
    const unsigned kb0 = (unsigned)(uintptr_t)Kl + (8 * fq + q4) * KP + 64 * w + 8 * p4, vzb0 = (unsigned)(uintptr_t)Vzl + (8 * fq + q4) * VP + 8 * p4;
    const unsigned koff = (unsigned)(((tid >> 5) * D + (tid & 31) * 8) * 2);
    const unsigned voff = (unsigned)(((tid >> 3) * RVW + (tid & 7) * 8) * 2);
    const unsigned qoff = (unsigned)(((16 * w + fr) * D + 8 * fq) * 2);
    for (int uidx = (G == 256) ? ((c & 7) * 32 + (c >> 3)) : c; uidx < 256; uidx += G) {
        const int b = uidx >> 7, h = (uidx >> 3) & 15, sl = uidx & 7;
        float l2g; { const double xg = 1.0 / (double)(1 << (5 + h)); double s = 0.0, p = xg; for (int k = 1; k <= 12; ++k) { s += p / k; p *= xg; } l2g = (float)(-s * 1.4426950408889634); }
        const float dchunk = fast_exp2(128.0f * l2g);
        f32x4 racc[2][4];
#pragma unroll
        for (int d = 0; d < 2; ++d)
#pragma unroll
            for (int cv = 0; cv < 4; ++cv) racc[d][cv] = zero4();
        __syncthreads();
        u32x4 kreg[8]; bf16x8 qf[8];
        { const char* kb = (const char*)(KR + (size_t)(b * SEQ) * D + h * 256); const char* qb = (const char*)(QR + (size_t)(b * SEQ) * D + h * 256);
#pragma unroll
          for (int i = 0; i < 8; ++i) kreg[i] = *(const u32x4*)(kb + (size_t)i * 16 * D * 2 + koff);
#pragma unroll
          for (int ks = 0; ks < 8; ++ks) qf[ks] = *(const bf16x8*)(qb + ks * 64 + qoff); }
        for (int nc = 0; nc < 32; ++nc) {
            const int t0 = b * SEQ + nc * 128;
#pragma unroll
            for (int d = 0; d < 2; ++d)
#pragma unroll
                for (int cv = 0; cv < 4; ++cv) { u32x2 wv; wv.x = cvt_pk_bf16(racc[d][cv][0], racc[d][cv][1]); wv.y = cvt_pk_bf16(racc[d][cv][2], racc[d][cv][3]);
                    *(LAS u32x2*)(Rl + (16 * cv + fr) * KP + (32 * w + 16 * d + 4 * fq) * 2) = wv; }
#pragma unroll
            for (int i = 0; i < 8; ++i) { const int id = tid + 512 * i, row = id >> 5, ch = id & 31; *(LAS u32x4*)(Kl + row * KP + ch * 16) = kreg[i]; }
#pragma unroll
            for (int i = 0; i < 2; ++i) { const int id = tid + 512 * i, row = id >> 3, ch = id & 7;
                const u32x4 vv = *(const u32x4*)((const char*)(VV + (size_t)t0 * RVW + h * 512 + sl * 64) + (size_t)i * 64 * RVW * 2 + voff); const float zt = fast_exp2((float)(127 - row) * l2g);
                u32x4 vz; vz.x = cvt_pk_bf16(bf_lo(vv.x) * zt, bf_hi(vv.x) * zt); vz.y = cvt_pk_bf16(bf_lo(vv.y) * zt, bf_hi(vv.y) * zt); vz.z = cvt_pk_bf16(bf_lo(vv.z) * zt, bf_hi(vv.z) * zt); vz.w = cvt_pk_bf16(bf_lo(vv.w) * zt, bf_hi(vv.w) * zt);
                *(LAS u32x4*)(Vl + row * VP + ch * 16) = vv; *(LAS u32x4*)(Vzl + row * VP + ch * 16) = vz; }
            const int tokq = t0 + 16 * w + fr;
            __syncthreads();
            if (nc + 1 < 32) { const char* kb = (const char*)(KR + (size_t)(t0 + 128) * D + h * 256);
#pragma unroll
                for (int i = 0; i < 8; ++i) kreg[i] = *(const u32x4*)(kb + (size_t)i * 16 * D * 2 + koff); }
            f32x4 oi[4];
#pragma unroll
            for (int cv = 0; cv < 4; ++cv) oi[cv] = zero4();
            if (nc > 0) {
                bf16x8 rA[4], rB[4];
#define RET_RLD(r, ks) { _Pragma("unroll") for (int cv = 0; cv < 4; ++cv) r[cv] = *(const LAS bf16x8*)(Rl + (16 * cv + fr) * KP + (32 * (ks) + 8 * fq) * 2); }
#define RET_RMM(r, ks) { _Pragma("unroll") for (int cv = 0; cv < 4; ++cv) oi[cv] = __builtin_amdgcn_mfma_f32_16x16x32_bf16(r[cv], qf[ks], oi[cv], 0, 0, 0); }
                RET_RLD(rA, 0) __builtin_amdgcn_sched_barrier(0);
                RET_RLD(rB, 1) __builtin_amdgcn_sched_barrier(0); RET_RMM(rA, 0) __builtin_amdgcn_sched_barrier(0);
                RET_RLD(rA, 2) __builtin_amdgcn_sched_barrier(0); RET_RMM(rB, 1) __builtin_amdgcn_sched_barrier(0);
                RET_RLD(rB, 3) __builtin_amdgcn_sched_barrier(0); RET_RMM(rA, 2) __builtin_amdgcn_sched_barrier(0);
                RET_RLD(rA, 4) __builtin_amdgcn_sched_barrier(0); RET_RMM(rB, 3) __builtin_amdgcn_sched_barrier(0);
                RET_RLD(rB, 5) __builtin_amdgcn_sched_barrier(0); RET_RMM(rA, 4) __builtin_amdgcn_sched_barrier(0);
                RET_RLD(rA, 6) __builtin_amdgcn_sched_barrier(0); RET_RMM(rB, 5) __builtin_amdgcn_sched_barrier(0);
                RET_RLD(rB, 7) __builtin_amdgcn_sched_barrier(0); RET_RMM(rA, 6) __builtin_amdgcn_sched_barrier(0);
                RET_RMM(rB, 7) __builtin_amdgcn_sched_barrier(0);
#undef RET_RLD
#undef RET_RMM
                const float xi = fast_exp2((float)(16 * w + fr + 1) * l2g);
#pragma unroll
                for (int cv = 0; cv < 4; ++cv) oi[cv] = oi[cv] * xi;
            }
            float dbase[4]; { float l2o = l2g; OPAQUE_V(l2o);
#pragma unroll
              for (int ii = 0; ii < 4; ++ii) dbase[ii] = fast_exp2((float)(fr - 4 * fq - ii) * l2o); }
#define RET_AB(S) if (2 * (S) <= w) { f32x4 st[2]; st[0] = zero4(); st[1] = zero4(); const bool two = 2 * (S) + 1 <= w; \
                { bf16x8 k0[4], k1[4];     \
                  _Pragma("unroll") for (int hk = 0; hk < 2; ++hk) { \
                  _Pragma("unroll") for (int ks = 0; ks < 4; ++ks) k0[ks] = *(const LAS bf16x8*)(Kl + (16 * (2 * (S)) + fr) * KP + (32 * (4 * hk + ks) + 8 * fq) * 2); \
                  _Pragma("unroll") for (int ks = 0; ks < 4; ++ks) k1[ks] = *(const LAS bf16x8*)(Kl + (16 * (two ? 2 * (S) + 1 : 2 * (S)) + fr) * KP + (32 * (4 * hk + ks) + 8 * fq) * 2); \
                  __builtin_amdgcn_sched_barrier(0); \
                  _Pragma("unroll") for (int ks = 0; ks < 4; ++ks) { st[0] = __builtin_amdgcn_mfma_f32_16x16x32_bf16(k0[ks], qf[4 * hk + ks], st[0], 0, 0, 0); st[1] = __builtin_amdgcn_mfma_f32_16x16x32_bf16(k1[ks], qf[4 * hk + ks], st[1], 0, 0, 0); } \
                  __builtin_amdgcn_sched_barrier(0); } } \
                _Pragma("unroll") for (int hb = 0; hb < 2; ++hb) { const int kb = 2 * (S) + hb; \
                    if (kb <= w) { const float bfac = fast_exp2((float)(16 * (w - kb)) * l2g); \
                        _Pragma("unroll") for (int ii = 0; ii < 4; ++ii) { const float f = dbase[ii] * bfac; st[hb][ii] = (kb < w || fr - 4 * fq - ii >= 0) ? st[hb][ii] * f : 0.f; } } \
                    else st[hb] = zero4(); } \
                u32x4 pw; pw.x = cvt_pk_bf16(st[0][0], st[0][1]); pw.y = cvt_pk_bf16(st[0][2], st[0][3]); pw.z = cvt_pk_bf16(st[1][0], st[1][1]); pw.w = cvt_pk_bf16(st[1][2], st[1][3]); \
                const bf16x8 pf = __builtin_bit_cast(bf16x8, pw); s16x4 lo[4], hi[4]; \
                tr_read8<32 * VP * (S), 32 * VP * (S) + 16 * VP>(vb0, lo, hi); \
                _Pragma("unroll") for (int cv = 0; cv < 4; ++cv) oi[cv] = __builtin_amdgcn_mfma_f32_16x16x32_bf16(cat4(lo[cv], hi[cv]), pf, oi[cv], 0, 0, 0); }
            RET_AB(0) RET_AB(1) RET_AB(2) RET_AB(3)
#undef RET_AB
            { float s1 = 0.f, s2 = 0.f;
#pragma unroll
              for (int cv = 0; cv < 4; ++cv) { s1 += (oi[cv][0] + oi[cv][1]) + (oi[cv][2] + oi[cv][3]); s2 += (oi[cv][0] * oi[cv][0] + oi[cv][1] * oi[cv][1]) + (oi[cv][2] * oi[cv][2] + oi[cv][3] * oi[cv][3]); }
              s1 += shx(s1, 16, lane); s1 += shx(s1, 32, lane); s2 += shx(s2, 16, lane); s2 += shx(s2, 32, lane);
              if (fq == 0) *(f32x2*)(SPp + ((size_t)(tokq * 16 + h) * 8 + sl) * 2) = (f32x2){s1, s2};
#pragma unroll
              for (int cv = 0; cv < 4; ++cv) { const f32x4 o = oi[cv]; u32x2 wv; wv.x = cvt_pk_bf16(o[0], o[1]); wv.y = cvt_pk_bf16(o[2], o[3]);
                  *(u32x2*)(OR + (size_t)tokq * RVW + h * 512 + sl * 64 + 16 * cv + 4 * fq) = wv; } }
            if (nc + 1 < 32) {
                { const char* qb = (const char*)(QR + (size_t)(t0 + 128) * D + h * 256);
#pragma unroll
                  for (int ks = 0; ks < 8; ++ks) qf[ks] = *(const bf16x8*)(qb + ks * 64 + qoff); } }
#pragma unroll
            for (int d = 0; d < 2; ++d)
#pragma unroll
                for (int cv = 0; cv < 4; ++cv) racc[d][cv] = racc[d][cv] * dchunk;
#define RET_C(S) { s16x4 klo[2], khi[2], vlo[4], vhi[4]; \
                tr_read2<32 * KP * (S), 32 * KP * (S) + 4 * KP>(kb0, klo[0], khi[0]); tr_read2<32 * KP * (S) + 32, 32 * KP * (S) + 4 * KP + 32>(kb0, klo[1], khi[1]); \
                tr_read8<32 * VP * (S), 32 * VP * (S) + 4 * VP>(vzb0, vlo, vhi); \
                _Pragma("unroll") for (int d = 0; d < 2; ++d) _Pragma("unroll") for (int cv = 0; cv < 4; ++cv) \
                    racc[d][cv] = __builtin_amdgcn_mfma_f32_16x16x32_bf16(cat4(klo[d], khi[d]), cat4(vlo[cv], vhi[cv]), racc[d][cv], 0, 0, 0); }
            RET_C(0) RET_C(1) RET_C(2) RET_C(3)
#undef RET_C
            __syncthreads();
        }
    }
}
__device__ __forceinline__ void phase_gn(CArgs& a, LAS unsigned char* lds, int j, int G, int c, int wv, bool dry) {
    const int tid = opaque_tid(wv), lane = tid & 63, wave = tid >> 6;
    bf16_t* OR = (bf16_t*)(a.ws + WS_ACT + ACT_OR); const bf16_t* SG = (const bf16_t*)(a.ws + WS_ACT + ACT_SG); const float* gng = a.gn_gain + (size_t)j * RVW;
    LAS float* TL = (LAS float*)lds;
    for (int i = tid; i < RVW / 4; i += 512) *(LAS f32x4*)(TL + 4 * i) = *(const f32x4*)(gng + 4 * i);
    __syncthreads();
    for (int row = c * 8 + wave; row < T; row += G * 8) {
        unsigned go = (unsigned)(uintptr_t)TL; OPAQUE_S(go); const LAS float* gl = (const LAS float*)(uintptr_t)go;
#pragma unroll 8
        for (int hh = 0; hh < 16; ++hh) { const size_t off = (size_t)row * RVW + 512 * hh + 8 * lane;
            const u32x4 ov = *(const u32x4*)(OR + off); const u32x4 gv = *(const u32x4*)(SG + off);
            float v[8] = {bf_lo(ov.x), bf_hi(ov.x), bf_lo(ov.y), bf_hi(ov.y), bf_lo(ov.z), bf_hi(ov.z), bf_lo(ov.w), bf_hi(ov.w)};
            const float g[8] = {bf_lo(gv.x), bf_hi(gv.x), bf_lo(gv.y), bf_hi(gv.y), bf_lo(gv.z), bf_hi(gv.z), bf_lo(gv.w), bf_hi(gv.w)};
            float s = 0.f;
#pragma unroll
            for (int k = 0; k < 8; ++k) s += v[k];
            const float mu = wave_sum(s, lane) * (1.0f / 512.0f); float q = 0.f;
#pragma unroll
            for (int k = 0; k < 8; ++k) { v[k] -= mu; q += v[k] * v[k]; }
            const float rstd = 1.0f / sqrtf(wave_sum(q, lane) * (1.0f / 512.0f) + GN_EPS);
            const f32x4 ga = *(const LAS f32x4*)(gl + 512 * hh + 8 * lane), gb = *(const LAS f32x4*)(gl + 512 * hh + 8 * lane + 4);
            const float gn[8] = {ga[0], ga[1], ga[2], ga[3], gb[0], gb[1], gb[2], gb[3]};
            float o[8];
#pragma unroll
            for (int k = 0; k < 8; ++k) o[k] = g[k] * (v[k] * rstd * gn[k]);
            u32x4 wv; wv.x = cvt_pk_bf16(o[0], o[1]); wv.y = cvt_pk_bf16(o[2], o[3]); wv.z = cvt_pk_bf16(o[4], o[5]); wv.w = cvt_pk_bf16(o[6], o[7]);
            *(u32x4*)((dry ? (bf16_t*)(a.ws + WS_Z) : OR) + off) = wv; }
    }
}

constexpr int NPHASE = 3 + 9 * NLAYER;
__device__ __forceinline__ CArgs& fresh_args() { CArgs* p = (CArgs*)__builtin_amdgcn_kernarg_segment_ptr(); OPAQUE_S(p); return *p; }
__global__ void __launch_bounds__(512, 2) mk_fwd(Args a_byval) {
    extern __shared__ __attribute__((aligned(16))) unsigned char lds_raw[];
    LAS unsigned char* lds = (LAS unsigned char*)lds_raw;
    const int G = gridDim.x, c = blockIdx.x;
    const int wv = __builtin_amdgcn_readfirstlane((int)threadIdx.x >> 6);
    { const int tid = opaque_tid(wv); for (int i = tid; i < (LDS_BYTES - LDSCTL_OFF) / 4; i += 512) ((LAS unsigned*)(lds + LDSCTL_OFF))[i] = 0u; }
    __syncthreads();
    { CArgs& a = fresh_args(); if (a.use_bar) { const int tid = opaque_tid(wv); if (tid == 0) (void)xb_add((unsigned*)(a.ws + WS_CTL) + CW_BAR + XB_XCNT(xb_xcc_id()), 1u); } }
    int lo, hi; { CArgs& a = fresh_args(); lo = a.ph_lo; hi = a.ph_hi; }
#ifndef SELMASK
#define SELMASK 0xffffffffu
#endif
#define SEL(b) (((SELMASK) >> (b)) & 1u)
#ifndef REP_BIT
#define REP_BIT 31
#endif
#ifndef REP_N
#define REP_N 1
#endif
#define NREP(b) (((b) == REP_BIT) ? REP_N : 1)
#define IN(k) (lo <= (k) && (k) < hi)
#define SEAM(k) do { if (IN(k) && IN((k) + 1)) { CArgs& ab = fresh_args(); XcdBarrier b2; b2.bar = (unsigned*)(ab.ws + WS_CTL) + CW_BAR; b2.x = xb_xcc_id(); b2.st = (volatile LAS unsigned*)(lds + LDSCTL_OFF + 512); xcd_barrier(b2, opaque_tid(wv)); } } while (0)
    for (int rp_ = 0; rp_ < NREP(0); ++rp_) { if (SEL(0) && IN(0)) { phase_prep(fresh_args(), lds, G, c, wv); } SEAM(0); }
    if (SEL(1) && IN(1)) { phase_modreduce(fresh_args(), G, c, wv); } SEAM(1);
    for (int rp_ = 0; rp_ < NREP(2); ++rp_) { if (SEL(2) && IN(2)) { phase_u0(fresh_args(), lds, G, c, wv); } SEAM(2); }
    for (int layer = 0; layer < NLAYER; ++layer) {
        const int pb = 3 + 9 * layer, j = layer >> 1;
        if ((layer & 1) == 0) {
            for (int rp_ = 0; rp_ < NREP(3); ++rp_) { if (SEL(3) && IN(pb + 0)) { CArgs& a = fresh_args(); unsigned char* ws = a.ws; pg8::StaticOrder S; S.init((const bf16_t*)(ws + WS_U), (const bf16_t*)(ws + WS_W + W_QKV) + (size_t)j * QKVN * D, T, QKVN, D, G, c);
                pg8::EpiQKV E{(bf16_t*)(ws + WS_ACT + ACT_QKV), (const float*)(ws + WS_BQKV) + j * QKVN, (const float*)(ws + WS_CSA), (const float*)(ws + WS_CSA) + T * 8};
                pg8::gemm_phase<pg8::EpiQKV, pg8::StaticOrder, false>(lds, D, S, E, wv);
                { const int idle0 = S.nwg % G;
                  if (idle0 > 0 && c >= idle0) { const int tid = opaque_tid(wv); prep_items(fresh_args(), lds, __builtin_amdgcn_readfirstlane(tid >> 6), tid & 63, (c - idle0) * 8 + __builtin_amdgcn_readfirstlane(tid >> 6), (G - idle0) * 8, 1 + (layer >> 1)); __syncthreads(); } } } SEAM(pb + 0); }
            for (int rp_ = 0; rp_ < NREP(4); ++rp_) { if (SEL(4) && IN(pb + 1)) { phase_attn(fresh_args(), lds, j, G, c, wv); } SEAM(pb + 1); }
        } else {
            for (int rp_ = 0; rp_ < NREP(5); ++rp_) { if (SEL(5) && IN(pb + 0)) { CArgs& a = fresh_args(); unsigned char* ws = a.ws; pg8::StaticOrder S; S.init((const bf16_t*)(ws + WS_U), (const bf16_t*)(ws + WS_W + W_RET) + (size_t)j * RETN * D, T, RET_QKV, D, G, c);
                pg8::EpiRet E{(bf16_t*)(ws + WS_ACT + ACT_QR), (bf16_t*)(ws + WS_ACT + ACT_KR), (bf16_t*)(ws + WS_ACT + ACT_VV), (const float*)(ws + WS_CSR)};
                pg8::gemm_phase<pg8::EpiRet, pg8::StaticOrder, false>(lds, D, S, E, wv); } SEAM(pb + 0); }
            for (int rp_ = 0; rp_ < NREP(6); ++rp_) { if (SEL(6) && IN(pb + 1)) { phase_ret(fresh_args(), lds, G, c, wv); } SEAM(pb + 1); }
            for (int rp_ = NREP(7) - 1; rp_ >= 0; --rp_) { if (SEL(7) && IN(pb + 2)) { CArgs& a = fresh_args(); unsigned char* ws = a.ws; pg8::StaticOrder S; S.init((const bf16_t*)(ws + WS_U), (const bf16_t*)(ws + WS_W + W_RET) + ((size_t)j * RETN + RET_QKV) * D, T, RVW, D, G, c);
                pg8::EpiG E{(bf16_t*)(ws + WS_ACT + ACT_OR), (const float*)(ws + WS_SP), a.gn_gain + (size_t)j * RVW, (LAS float*)(lds + LDS_GNST), (bf16_t*)(ws + WS_ACT + (rp_ > 0 ? ACT_SG : ACT_OR))};
                pg8::gemm_phase<pg8::EpiG, pg8::StaticOrder, false>(lds, D, S, E, wv); } SEAM(pb + 2); }
        }
        for (int rp_ = 0; rp_ < NREP(8); ++rp_) { if (SEL(8) && IN(pb + 3)) { CArgs& a = fresh_args(); unsigned char* ws = a.ws; const bool at = (layer & 1) == 0; const int K = at ? D : RVW;
            pg8::StaticOrder S; S.init(at ? (const bf16_t*)(ws + WS_ACT + ACT_O) : (const bf16_t*)(ws + WS_ACT + ACT_OR), at ? (const bf16_t*)(ws + WS_W + W_OA) + (size_t)j * D * D : (const bf16_t*)(ws + WS_W + W_OR) + (size_t)j * D * RVW, T, D, K, G, c);
            pg8::EpiZ E{(bf16_t*)(ws + WS_Z), at ? a.b_oa + (size_t)j * D : nullptr, (const float*)(ws + WS_MODL) + (size_t)layer * 2 * 24576 + 2 * D};
            pg8::gemm_phase<pg8::EpiZ, pg8::StaticOrder, false>(lds, K, S, E, wv); } SEAM(pb + 3); }
        for (int rp_ = NREP(9) - 1; rp_ >= 0; --rp_) { if (SEL(9) && IN(pb + 4)) { phase_ln1(fresh_args(), lds, layer, G, c, wv, rp_ > 0); } SEAM(pb + 4); }
        for (int rp_ = 0; rp_ < NREP(10); ++rp_)
        for (int st = 0; st < 3; ++st) { const int ph = pb + 5 + st;
            if (IN(ph)) { CArgs& a = fresh_args(); unsigned char* ws = a.ws; const int ntile = moe_tables(a, lds, layer, wv, st > 0 && lo < ph);
                const int cx = (G == 256) ? ((c & 7) * 32 + (c >> 3)) : c;
                const int Ub = 2 * ntile, R1 = (Ub >= G ? (Ub / G) * G : Ub) & ~1, nlate = Ub - R1, Dm = (R1 >> 1) * 16;
                if (SEL(10) && (st == 0 || (st == 1 && cx < nlate))) {
                    pg8::GuOrder S{G, cx, st == 0 ? 0 : R1, st == 0 ? R1 : Ub, (const LAS int*)(lds + LDSCTL_OFF), (const LAS int*)(lds + LDSCTL_OFF) + 64, (const int*)(ws + WS_ROWS), (const bf16_t*)(ws + WS_U), (const bf16_t*)(ws + WS_W + W_GU) + (size_t)layer * NEXP * GUW * D};
                    pg8::EpiGU E{(bf16_t*)(ws + WS_ACT + ACT_H), a.b_gu + (size_t)layer * NEXP * GUW};
                    pg8::gemm_phase<pg8::EpiGU, pg8::GuOrder, true>(lds, D, S, E, wv); }
                if (SEL(11) && st >= 1) {
                    pg8::DownOrder S{G, cx, st == 1 ? 0 : Dm, st == 1 ? Dm : ntile * 16, st == 1 ? nlate : 0, (const LAS int*)(lds + LDSCTL_OFF), (const LAS int*)(lds + LDSCTL_OFF) + 64, (const bf16_t*)(ws + WS_ACT + ACT_H), (const bf16_t*)(ws + WS_W + W_DN) + (size_t)layer * NEXP * D * EFF};
                    pg8::EpiDown E{(unsigned char*)(ws + WS_ACT + ACT_YP), a.b_dn + (size_t)layer * NEXP * D};
                    pg8::gemm_phase<pg8::EpiDown, pg8::DownOrder, false>(lds, a.k_dn, S, E, wv); } }
            SEAM(ph); }
        for (int rp_ = NREP(12) - 1; rp_ >= 0; --rp_) { if (SEL(12) && IN(pb + 8)) { phase_ln2(fresh_args(), lds, layer, G, c, wv, rp_ > 0, lo < pb + 8); } SEAM(pb + 8); }
    }
#undef IN
#undef SEAM
}

extern "C" void kernel_launch(void* const* d_in, const int* in_sizes, int n_in, void* d_out, int out_size, void* d_ws, size_t ws_size, hipStream_t stream) {
    static int grid = 0;
    if (grid == 0) {
        if (n_in != 22 || ws_size < WS_END) { fprintf(stderr, "kernel_launch: unexpected n_in %d or ws_size %zu (< %zu)\n", n_in, ws_size, (size_t)WS_END); grid = -1; return; }
        int dev = 0, cus = 0, per_cu = 0;
        if (hipGetDevice(&dev) != hipSuccess || hipDeviceGetAttribute(&cus, hipDeviceAttributeMultiprocessorCount, dev) != hipSuccess) { grid = -1; return; }
        if (hipFuncSetAttribute((const void*)mk_fwd, hipFuncAttributeMaxDynamicSharedMemorySize, LDS_BYTES) != hipSuccess) { fprintf(stderr, "kernel_launch: hipFuncSetAttribute failed\n"); grid = -1; return; }
        if (hipOccupancyMaxActiveBlocksPerMultiprocessor(&per_cu, (const void*)mk_fwd, 512, LDS_BYTES) != hipSuccess || per_cu < 1) fprintf(stderr, "kernel_launch: occupancy query reports %d\n", per_cu);
        (void)hipGetLastError();
        grid = cus;
    }
    if (grid < 0) return;
    (void)hipMemsetAsync((char*)d_ws + WS_CTL, 0, CTL_BYTES, stream);
    Args a{};
    a.x = (const float*)d_in[0]; a.c = (const float*)d_in[1]; a.pos = (const int*)d_in[2]; a.mod_w = (const float*)d_in[3]; a.mod_b = (const float*)d_in[4]; a.mod_layer = (const float*)d_in[5];
    a.ln_gain = (const float*)d_in[6]; a.ln_bias = (const float*)d_in[7]; a.w_qkv = (const float*)d_in[8]; a.b_qkv = (const float*)d_in[9]; a.sinks = (const float*)d_in[10];
    a.w_oa = (const float*)d_in[11]; a.b_oa = (const float*)d_in[12]; a.w_ret = (const float*)d_in[13]; a.gn_gain = (const float*)d_in[14]; a.w_or = (const float*)d_in[15];
    a.router_w = (const float*)d_in[16]; a.router_b = (const float*)d_in[17]; a.w_gu = (const float*)d_in[18]; a.b_gu = (const float*)d_in[19]; a.w_dn = (const float*)d_in[20]; a.b_dn = (const float*)d_in[21];
    a.out = (float*)d_out; a.ws = (unsigned char*)d_ws; a.k_dn = EFF;
#if MK_ONE_LAUNCH
    a.ph_lo = 0; a.ph_hi = NPHASE; a.use_bar = 1;
    hipLaunchKernelGGL(mk_fwd, dim3(grid), dim3(512), LDS_BYTES, stream, a);
#else
    a.use_bar = 0;
    for (int p = 0; p < NPHASE; ++p) { if (p >= 3 && (((p - 3) / 9) & 1) == 0 && ((p - 3) % 9) == 2) continue;
        a.ph_lo = p; a.ph_hi = p + 1; hipLaunchKernelGGL(mk_fwd, dim3(grid), dim3(512), LDS_BYTES, stream, a); }
#endif
}
```

```cpp
#include <hip/hip_runtime.h>
#include <cstdio>
#include <cstdint>

#ifndef MK_ONE_LAUNCH
#define MK_ONE_LAUNCH 1
#endif

#define LAS __attribute__((address_space(3)))
typedef unsigned short bf16_t;
typedef short bf16x8 __attribute__((ext_vector_type(8)));
typedef short s16x4 __attribute__((ext_vector_type(4)));
typedef float f32x4 __attribute__((ext_vector_type(4)));
typedef float f32x2 __attribute__((ext_vector_type(2)));
typedef unsigned u32x4 __attribute__((ext_vector_type(4)));
typedef unsigned u32x2 __attribute__((ext_vector_type(2)));

constexpr int NB = 2, SEQ = 4096, T = NB * SEQ, D = 4096, NLAYER = 4;
constexpr int QKVN = 5120, RETN = 24576, RVW = 8192, RET_QKV = 16384;
constexpr int NEXP = 32, EFF = 256, GUW = 512, ECAP = 8192, MAXSLOT = 40960;
constexpr float ALPHA = 1.6817928305074290f;
constexpr float LN_EPS = 1e-5f, GN_EPS = 1e-6f;
constexpr float YP_SCALE = 8.0f;

constexpr size_t MiB = (size_t)1 << 20;
constexpr size_t WS_CTL = 0, CTL_BYTES = 1 * MiB;
constexpr size_t WS_MODP = 1 * MiB;
constexpr size_t WS_MODL = 8 * MiB;
constexpr size_t WS_CSA = 9 * MiB;
constexpr size_t WS_CSR = 10 * MiB;
constexpr size_t WS_BQKV = 18 * MiB;
constexpr size_t WS_TK = 19 * MiB;
constexpr size_t WS_ROWS = 20 * MiB;
constexpr size_t WS_U = 32 * MiB;
constexpr size_t WS_Z = 96 * MiB;
constexpr size_t WS_SP = WS_Z + 64 * MiB;
constexpr size_t WS_ACT = 224 * MiB;
constexpr size_t ACT_QKV = 0, ACT_O = 80 * MiB;
constexpr size_t ACT_QR = 0, ACT_KR = 64 * MiB, ACT_VV = 128 * MiB, ACT_SG = 256 * MiB, ACT_OR = 384 * MiB;
constexpr size_t ACT_H = 0, ACT_YP = 32 * MiB;
constexpr size_t WS_W = 736 * MiB;
constexpr size_t W_QKV = 0, W_OA = 80 * MiB, W_RET = 144 * MiB, W_OR = 528 * MiB, W_GU = 656 * MiB, W_DN = 1168 * MiB, W_END = 1424 * MiB;
constexpr size_t WS_XB = WS_W + W_END;
constexpr size_t WS_END = WS_XB + 64 * MiB;
constexpr int CW_BAR = 1024, CW_CNT = 8192;

constexpr int LDS_STAGE = 131072;
constexpr int LDSCTL_OFF = 149504;
constexpr int LDS_BYTES = 156672;
constexpr int LDS_GNST = LDSCTL_OFF + 3072;

typedef __bf16 bf16x2_t __attribute__((ext_vector_type(2)));
__device__ __forceinline__ unsigned cvt_pk_bf16(float lo, float hi) { const f32x2 v = {lo, hi}; return __builtin_bit_cast(unsigned, __builtin_convertvector(v, bf16x2_t)); }
typedef _Float16 h16x2_t __attribute__((ext_vector_type(2)));
__device__ __forceinline__ unsigned cvt_pk_f16(float lo, float hi) { const f32x2 v = {lo, hi}; return __builtin_bit_cast(unsigned, __builtin_convertvector(v, h16x2_t)); }
__device__ __forceinline__ float h_lo(unsigned w) { return (float)__builtin_bit_cast(h16x2_t, w)[0]; }
__device__ __forceinline__ float h_hi(unsigned w) { return (float)__builtin_bit_cast(h16x2_t, w)[1]; }
__device__ __forceinline__ float bf_lo(unsigned w) { return __uint_as_float(w << 16); }
__device__ __forceinline__ float bf_hi(unsigned w) { return __uint_as_float(w & 0xffff0000u); }
__device__ __forceinline__ float shx(float v, int mask, int lane) { return __int_as_float(__builtin_amdgcn_ds_bpermute((lane ^ mask) << 2, __float_as_int(v))); }
__device__ __forceinline__ float wave_sum(float v, int lane) {
#pragma unroll
    for (int o = 1; o < 64; o <<= 1) v += shx(v, o, lane);
    return v;
}
__device__ __forceinline__ u32x4 zero4u() { unsigned z = 0u; asm volatile("" : "+v"(z)); return (u32x4){z, z, z, z}; }
__device__ __forceinline__ f32x4 zero4() { float z = 0.f; asm volatile("" : "+v"(z)); return (f32x4){z, z, z, z}; }
__device__ __forceinline__ float fast_exp2(float x) { return __builtin_amdgcn_exp2f(x); }
__device__ __forceinline__ float fast_rcp(float x) { return __builtin_amdgcn_rcpf(x); }

#define OPAQUE_V(x) asm volatile("" : "+v"(x))
#define OPAQUE_S(x) asm volatile("" : "+s"(x))
__device__ __forceinline__ int opaque_tid(int wv) { unsigned m = ~0u; OPAQUE_S(m); int t = (wv << 6) | (int)__builtin_amdgcn_mbcnt_hi(m, __builtin_amdgcn_mbcnt_lo(m, 0u)); OPAQUE_V(t); return t; }
namespace pg8 {
constexpr int BM = 256, BK = 64, HALF = 128, HTB = HALF * BK * 2, STAGE_BYTES = 8 * HTB, NXCD = 8, WGM = 8;
__host__ __device__ __forceinline__ int lds_byte(int r, int c) { const int st = (r >> 4) * 2 + (c >> 5), rr = r & 15, cc = c & 31, ob = rr * 64 + cc * 2; return st * 1024 + (ob ^ (((ob >> 9) & 1) << 5)); }
__host__ __device__ __forceinline__ void stage_rc(int b, int& R, int& C) { const int st = b / 1024, sb = b % 1024, swz = sb ^ (((sb >> 9) & 1) << 5); R = (st >> 1) * 16 + swz / 64; C = (st & 1) * 32 + (swz % 64) / 2; }
__host__ __device__ __forceinline__ int perm32(int rho) { const int n = rho >> 4, i = rho & 15; return 8 * (i >> 2) + 4 * n + (i & 3); }

struct Unit { int pm, pn, e, rt, valid, seq; };

struct StaticOrder {
    static constexpr bool SKIP = false;
    int nM, nN, nwg, G, c; const bf16_t* A; const bf16_t* Bt; int K;
    __device__ void init(const bf16_t* A_, const bf16_t* Bt_, int M, int N, int K_, int G_, int c_) { A = A_; Bt = Bt_; K = K_; nM = M / BM; nN = N / BM; nwg = nM * nN; G = G_; c = c_; }
    __device__ __forceinline__ bool next(int i, Unit& u) const {
        const long L = (long)i * G + c; if (L >= nwg) return false;
        int wgid = (int)L; { const int q = nwg / NXCD, r = nwg % NXCD, xcd = wgid % NXCD, off = wgid / NXCD; wgid = (xcd < r ? xcd * (q + 1) : r * (q + 1) + (xcd - r) * q) + off; }
        const int nig = WGM * nN, gid = wgid / nig, fm = gid * WGM, gsz = (nM - fm) < WGM ? (nM - fm) : WGM;
        u = Unit{fm + ((wgid % nig) % gsz), (wgid % nig) / gsz, 0, 0, BM, i}; return true;
    }
    __device__ __forceinline__ const char* a_base(const Unit& u) const { return (const char*)A + (size_t)u.pm * BM * K * 2; }
    __device__ __forceinline__ const char* b_base(const Unit& u) const { return (const char*)Bt + (size_t)u.pn * BM * K * 2; }
    __device__ __forceinline__ int row_token(const Unit&, int r) const { return r; }
};

template <class Epi, class Sched, bool GATHER>
__device__ __forceinline__ void gemm_phase(LAS unsigned char* lds, const int K, const Sched& S, const Epi& E, const int wv) {
    const int tid = opaque_tid(wv), wid = __builtin_amdgcn_readfirstlane(tid >> 6), lane = tid & 63, wr = wid >> 2, wc = wid & 3, fr = lane & 15, fq = lane >> 4;
    const int nt = K / BK;
    unsigned voffB[2], cvA[2][2], nvA[2][2]; int Rr[2], Cc[2];
#pragma unroll
    for (int i = 0; i < 2; ++i) { int R, C; stage_rc(tid * 16 + i * 8192, R, C); Rr[i] = R; Cc[i] = C; const int Rb = Epi::WIDE ? (64 * (R >> 5) + 16 * ((R >> 2) & 3) + 4 * ((R >> 4) & 1) + (R & 3)) : Epi::PERM ? ((R & ~31) + perm32(R & 31)) : R;
        voffB[i] = (unsigned)(Rb * K + C) * 2u; }
    const size_t kstep = (size_t)(BK * 2);
    const size_t hstep = Epi::WIDE ? (size_t)8 * K * 2 : (size_t)HALF * K * 2;
    const unsigned ldsw = (unsigned)wid * 1024u;
    const int aoff = lds_byte(wr * 64 + fr, fq * 8), boff = lds_byte(wc * 32 + fr, fq * 8);
#define PG8_SA(b, h) (((b) * 2 + (h)) * HTB)
#define PG8_SB(b, h) ((4 + (b) * 2 + (h)) * HTB)
#define PG8_STAGE_B(bufoff, gbase) do { _Pragma("unroll") for (int _i = 0; _i < 2; ++_i) \
        __builtin_amdgcn_global_load_lds((const unsigned*)((const char*)(gbase) + voffB[_i]), (LAS unsigned*)(lds + (bufoff) + ldsw + _i * 8192), 16, 0, 0); } while (0)
#define PG8_STAGE_A(bufoff, gbase, v0, v1) do { \
        __builtin_amdgcn_global_load_lds((const unsigned*)((const char*)(gbase) + (v0)), (LAS unsigned*)(lds + (bufoff) + ldsw), 16, 0, 0); \
        __builtin_amdgcn_global_load_lds((const unsigned*)((const char*)(gbase) + (v1)), (LAS unsigned*)(lds + (bufoff) + ldsw + 8192), 16, 0, 0); } while (0)
#define PG8_LDA(dst, b, h) do { _Pragma("unroll") for (int m = 0; m < 4; ++m) _Pragma("unroll") for (int k = 0; k < 2; ++k) dst[m][k] = *(const LAS bf16x8*)(lds + PG8_SA(b, h) + aoff + m * 2048 + k * 1024); } while (0)
#define PG8_LDB(dst, b, h) do { _Pragma("unroll") for (int n = 0; n < 2; ++n) _Pragma("unroll") for (int k = 0; k < 2; ++k) dst[n][k] = *(const LAS bf16x8*)(lds + PG8_SB(b, h) + boff + n * 2048 + k * 1024); } while (0)
#define PG8_MMA(ai, bj, At, Bt) do { __builtin_amdgcn_s_setprio(1); if (Sched::SKIP) OPAQUE_S(mmask); _Pragma("unroll") for (int m = 0; m < 4; ++m) { if (!Sched::SKIP || __builtin_expect((mmask >> (4 * (ai) + m)) & 1, 1)) { _Pragma("unroll") for (int n = 0; n < 2; ++n) _Pragma("unroll") for (int k = 0; k < 2; ++k) \
        acc[ai][bj][m][n] = __builtin_amdgcn_mfma_f32_16x16x32_bf16(Bt[n][k], At[m][k], acc[ai][bj][m][n], 0, 0, 0); } } __builtin_amdgcn_s_setprio(0); } while (0)
#define PG8_WAIT_V(n) asm volatile("s_waitcnt vmcnt(" #n ")" ::: "memory")
#define PG8_WAIT_L(n) asm volatile("s_waitcnt lgkmcnt(" #n ")" ::: "memory")
#define PG8_BAR __builtin_amdgcn_s_barrier()
#define PG8_SCHED __builtin_amdgcn_sched_barrier(0)
    Unit cur, nxt; int ui = 0;
    if (!S.next(0, cur)) return;
    f32x4 acc[2][2][4][2];
    if constexpr (Epi::ACC_BIAS) { f32x4 bv0[2][2]; E.bias_load(cur, wc, fq, bv0);
#pragma unroll
        for (int a = 0; a < 2; ++a)
#pragma unroll
            for (int b = 0; b < 2; ++b)
#pragma unroll
                for (int m = 0; m < 4; ++m)
#pragma unroll
                    for (int n = 0; n < 2; ++n) acc[a][b][m][n] = bv0[b][n];
    } else {
#pragma unroll
    for (int a = 0; a < 2; ++a)
#pragma unroll
        for (int b = 0; b < 2; ++b)
#pragma unroll
            for (int m = 0; m < 4; ++m)
#pragma unroll
                for (int n = 0; n < 2; ++n) acc[a][b][m][n] = zero4();
    }
    bf16x8 At[4][2], B0[2][2], B1[2][2];
    int mmask = 255;
#define PG8_MCV(u) do { mmask = 0; _Pragma("unroll") for (int h_ = 0; h_ < 2; ++h_) { int q_ = ((u).valid - 128 * h_ - 64 * wr + 15) >> 4; q_ = q_ < 0 ? 0 : q_; q_ = q_ > 4 ? 4 : q_; mmask |= ((1 << q_) - 1) << (4 * h_); } mmask = __builtin_amdgcn_readfirstlane(mmask); } while (0)
    PG8_MCV(cur);
    const char* cA = S.a_base(cur); const char* cB = S.b_base(cur);
#pragma unroll
    for (int h = 0; h < 2; ++h)
#pragma unroll
        for (int i = 0; i < 2; ++i) { const int tok = GATHER ? S.row_token(cur, h * HALF + Rr[i]) : (h * HALF + Rr[i]); cvA[h][i] = (unsigned)(tok * K + Cc[i]) * 2u; nvA[h][i] = cvA[h][i]; }
    PG8_STAGE_B(PG8_SB(0, 0), cB); PG8_STAGE_B(PG8_SB(0, 1), cB + hstep); PG8_STAGE_A(PG8_SA(0, 0), cA, cvA[0][0], cvA[0][1]); PG8_STAGE_A(PG8_SA(0, 1), cA, cvA[1][0], cvA[1][1]);
    if (wr == 1) PG8_BAR;
    PG8_WAIT_V(2); PG8_BAR;
    PG8_STAGE_B(PG8_SB(1, 0), cB + kstep); PG8_STAGE_A(PG8_SA(1, 0), cA + kstep, cvA[0][0], cvA[0][1]); PG8_STAGE_B(PG8_SB(1, 1), cB + hstep + kstep);
    PG8_WAIT_V(6); PG8_BAR;
    for (;;) {
        const bool has_next = S.next(ui + 1, nxt);
        const char* nA = has_next ? S.a_base(nxt) : cA; const char* nB = has_next ? S.b_base(nxt) : cB;
        if (GATHER) {
#pragma unroll
            for (int h = 0; h < 2; ++h)
#pragma unroll
                for (int i = 0; i < 2; ++i) { if (has_next) { const int tok = S.row_token(nxt, h * HALF + Rr[i]); nvA[h][i] = (unsigned)(tok * K + Cc[i]) * 2u; } else nvA[h][i] = cvA[h][i]; }
        }
        for (int t = 0; t < nt; t += 2) {
            const bool last = (t == nt - 2);
            const char* a1 = cA + (size_t)(t + 1) * kstep;
            const char* a2 = last ? nA : cA + (size_t)(t + 2) * kstep; const char* b2 = last ? nB : cB + (size_t)(t + 2) * kstep;
            const char* a3 = a2 + kstep; const char* b3 = b2 + kstep;
            const unsigned w00 = (GATHER && last) ? nvA[0][0] : cvA[0][0], w01 = (GATHER && last) ? nvA[0][1] : cvA[0][1];
            const unsigned w10 = (GATHER && last) ? nvA[1][0] : cvA[1][0], w11 = (GATHER && last) ? nvA[1][1] : cvA[1][1];
            PG8_LDB(B0, 0, 0); PG8_LDB(B1, 0, 1); PG8_SCHED; PG8_LDA(At, 0, 0); PG8_STAGE_A(PG8_SA(1, 1), a1, cvA[1][0], cvA[1][1]);
            PG8_WAIT_V(8); PG8_WAIT_L(0); PG8_BAR; PG8_MMA(0, 0, At, B0); PG8_MMA(0, 1, At, B1); PG8_BAR; PG8_SCHED;
            PG8_LDA(At, 0, 1); PG8_STAGE_B(PG8_SB(0, 0), b2); PG8_STAGE_B(PG8_SB(0, 1), b2 + hstep); PG8_STAGE_A(PG8_SA(0, 0), a2, w00, w01);
            PG8_WAIT_V(8); PG8_WAIT_L(0); PG8_BAR; PG8_MMA(1, 0, At, B0); PG8_MMA(1, 1, At, B1); PG8_BAR; PG8_SCHED;
            PG8_LDB(B0, 1, 0); PG8_LDB(B1, 1, 1); PG8_SCHED; PG8_LDA(At, 1, 0); PG8_STAGE_A(PG8_SA(0, 1), a2, w10, w11);
            PG8_WAIT_V(8); PG8_WAIT_L(0); PG8_BAR; PG8_MMA(0, 0, At, B0); PG8_MMA(0, 1, At, B1); PG8_BAR; PG8_SCHED;
            PG8_LDA(At, 1, 1); PG8_STAGE_B(PG8_SB(1, 0), b3); PG8_STAGE_B(PG8_SB(1, 1), b3 + hstep); PG8_STAGE_A(PG8_SA(1, 0), a3, w00, w01);
            PG8_WAIT_V(8); PG8_WAIT_L(0); PG8_BAR; PG8_MMA(1, 0, At, B0); PG8_MMA(1, 1, At, B1); PG8_BAR; PG8_SCHED;
        }
        if (wr == 0) PG8_BAR;
        f32x4 nbv[2][2];
        if constexpr (Epi::ACC_BIAS) { E.bias_load_untracked(has_next ? nxt : cur, wc, fq, nbv); PG8_SCHED; }
        E(acc, cur, wr, wc, fr, fq);
        if constexpr (Epi::ACC_BIAS) { static_assert(Epi::NSTORE == 8, "counted wait below"); asm volatile("s_waitcnt vmcnt(6)" : "+v"(nbv[0][0]), "+v"(nbv[0][1]), "+v"(nbv[1][0]), "+v"(nbv[1][1]) :: "memory"); }
        if (!has_next) break;
#pragma unroll
        for (int a = 0; a < 2; ++a)
#pragma unroll
            for (int b = 0; b < 2; ++b)
#pragma unroll
                for (int m = 0; m < 4; ++m)
#pragma unroll
                    for (int n = 0; n < 2; ++n) { if constexpr (Epi::ACC_BIAS) acc[a][b][m][n] = nbv[b][n]; else acc[a][b][m][n] = zero4(); }
        cur = nxt; cA = nA; cB = nB; ++ui; PG8_MCV(cur);
#pragma unroll
        for (int h = 0; h < 2; ++h)
#pragma unroll
            for (int i = 0; i < 2; ++i) cvA[h][i] = nvA[h][i];
        if (wr == 1) PG8_BAR;
    }
    PG8_WAIT_V(0);
    PG8_BAR;
#undef PG8_MCV
#undef PG8_SA
#undef PG8_SB
#undef PG8_STAGE_A
#undef PG8_STAGE_B
#undef PG8_LDA
#undef PG8_LDB
#undef PG8_MMA
#undef PG8_WAIT_V
#undef PG8_WAIT_L
#undef PG8_BAR
#undef PG8_SCHED
}

struct EpiQKV {
    static constexpr bool PERM = true; static constexpr bool WIDE = false; static constexpr bool ACC_BIAS = false;
    bf16_t* O; const float* bias; const float* cosA; const float* sinA;
    __device__ __forceinline__ void operator()(const f32x4 (&acc)[2][2][4][2], const Unit& u, int wr, int wc, int fr, int fq) const {
        const int row0 = u.pm * BM + wr * 64 + fr, col0 = u.pn * BM + wc * 32 + 8 * fq;
        const bool rope = (u.pn < 18) && ((wc & 1) == 0) && (fq < 2);
        f32x4 bv[2][2];
#pragma unroll
        for (int bj = 0; bj < 2; ++bj)
#pragma unroll
            for (int n = 0; n < 2; ++n) bv[bj][n] = *(const f32x4*)(bias + col0 + bj * HALF + 4 * n);
#pragma unroll
        for (int ai = 0; ai < 2; ++ai)
#pragma unroll
            for (int m = 0; m < 4; ++m) { const int row = row0 + ai * HALF + m * 16;
                f32x4 cs = *(const f32x4*)(cosA + (size_t)row * 8 + 4 * (fq & 1)), sn = *(const f32x4*)(sinA + (size_t)row * 8 + 4 * (fq & 1));

#pragma unroll
                for (int jx = 0; jx < 4; ++jx) { cs[jx] = rope ? cs[jx] : 1.0f; sn[jx] = rope ? sn[jx] : 0.0f; }
                bf16_t* rowp = O + (size_t)row * QKVN + col0;
#pragma unroll
                for (int bj = 0; bj < 2; ++bj) { const f32x4 v0 = acc[ai][bj][m][0] + bv[bj][0], v1 = acc[ai][bj][m][1] + bv[bj][1];
                    const f32x4 o0 = v0 * cs - v1 * sn, o1 = v1 * cs + v0 * sn;
                    u32x4 w; w.x = cvt_pk_bf16(o0[0], o0[1]); w.y = cvt_pk_bf16(o0[2], o0[3]); w.z = cvt_pk_bf16(o1[0], o1[1]); w.w = cvt_pk_bf16(o1[2], o1[3]);
                    *(u32x4*)(rowp + bj * HALF) = w; } }
    }
};
struct EpiRet {
    static constexpr bool PERM = true; static constexpr bool WIDE = false; static constexpr bool ACC_BIAS = false;
    bf16_t *QR, *KR, *VV; const float* csR;
    __device__ __forceinline__ void operator()(const f32x4 (&acc)[2][2][4][2], const Unit& u, int wr, int wc, int fr, int fq) const {
        const int row0 = u.pm * BM + wr * 64 + fr, colt = wc * 32 + 8 * fq, pn = u.pn;
        if (pn < 32) {
            bf16_t* dst = pn < 16 ? QR : KR; const int hc = (pn & 15) * 256; const float sc = pn < 16 ? 1.f : 0.0625f;
#pragma unroll
            for (int ai = 0; ai < 2; ++ai)
#pragma unroll
                for (int m = 0; m < 4; ++m) { const int row = row0 + ai * HALF + m * 16;
#pragma unroll
                    for (int bj = 0; bj < 2; ++bj) { f32x4 o[2];
#pragma unroll
                        for (int n = 0; n < 2; ++n) { const int i0 = 64 * bj + 16 * wc + 4 * fq + 2 * n;
                            const f32x4 t = *(const f32x4*)(csR + ((size_t)row * 128 + i0) * 2); const f32x4 v = acc[ai][bj][m][n];
                            o[n] = (f32x4){(v[0] * t[0] - v[1] * t[1]) * sc, (v[1] * t[0] + v[0] * t[1]) * sc, (v[2] * t[2] - v[3] * t[3]) * sc, (v[3] * t[2] + v[2] * t[3]) * sc}; }
                        u32x4 w; w.x = cvt_pk_bf16(o[0][0], o[0][1]); w.y = cvt_pk_bf16(o[0][2], o[0][3]); w.z = cvt_pk_bf16(o[1][0], o[1][1]); w.w = cvt_pk_bf16(o[1][2], o[1][3]);
                        *(u32x4*)(dst + (size_t)row * D + hc + bj * HALF + colt) = w; } }
        } else {
            bf16_t* dst = VV; const int hc = (pn - 32) * 256;
#pragma unroll
            for (int ai = 0; ai < 2; ++ai)
#pragma unroll
                for (int m = 0; m < 4; ++m) { const int row = row0 + ai * HALF + m * 16;
#pragma unroll
                    for (int bj = 0; bj < 2; ++bj) { f32x4 o[2];
#pragma unroll
                        for (int n = 0; n < 2; ++n) o[n] = acc[ai][bj][m][n];
                        u32x4 w; w.x = cvt_pk_bf16(o[0][0], o[0][1]); w.y = cvt_pk_bf16(o[0][2], o[0][3]); w.z = cvt_pk_bf16(o[1][0], o[1][1]); w.w = cvt_pk_bf16(o[1][2], o[1][3]);
                        *(u32x4*)(dst + (size_t)row * RVW + hc + bj * HALF + colt) = w; } }
        }
    }
};
struct EpiG {
    static constexpr bool PERM = true; static constexpr bool WIDE = false; static constexpr bool ACC_BIAS = false;
    bf16_t* OR; const float* SP; const float* gng; LAS float* st; bf16_t* OW;
    __device__ __forceinline__ void operator()(const f32x4 (&acc)[2][2][4][2], const Unit& u, int wr, int wc, int fr, int fq) const {
        const int tid = (wr * 4 + wc) * 64 + fq * 16 + fr, h = u.pn >> 1; LAS float* sb = st + (u.seq & 1) * 512;
        const int row0 = u.pm * BM + wr * 64 + fr, col0 = u.pn * BM + wc * 32 + 8 * fq;
        u32x4 ob[2][2];
#pragma unroll
        for (int m = 0; m < 2; ++m)
#pragma unroll
            for (int bj = 0; bj < 2; ++bj) ob[m][bj] = *(const u32x4*)(OR + (size_t)(row0 + m * 16) * RVW + col0 + bj * HALF);
        f32x4 gv[2][2];
#pragma unroll
        for (int bj = 0; bj < 2; ++bj)
#pragma unroll
            for (int n = 0; n < 2; ++n) gv[bj][n] = *(const f32x4*)(gng + col0 + bj * HALF + 4 * n);
        if (tid < 256) { const float* p = SP + ((size_t)(u.pm * BM + tid) * 16 + h) * 16; float s1 = 0.f, s2 = 0.f;
#pragma unroll
            for (int k = 0; k < 4; ++k) { const f32x4 t = *(const f32x4*)(p + 4 * k); s1 += t[0] + t[2]; s2 += t[1] + t[3]; }
            const float mean = s1 * (1.0f / 512.0f), var = fmaxf(s2 * (1.0f / 512.0f) - mean * mean, 0.f);
            sb[2 * tid] = mean; sb[2 * tid + 1] = 1.0f / sqrtf(var + GN_EPS); }
        asm volatile("s_waitcnt lgkmcnt(0)" ::: "memory"); __builtin_amdgcn_s_barrier(); asm volatile("" ::: "memory");
#pragma unroll
        for (int am = 0; am < 4; ++am) { const int ai = am >> 1, m0 = 2 * (am & 1); u32x4 oc[2][2];
#pragma unroll
            for (int m = 0; m < 2; ++m)
#pragma unroll
                for (int bj = 0; bj < 2; ++bj) oc[m][bj] = ob[m][bj];
            if (am < 3) { const int an = am + 1, ain = an >> 1, mn = 2 * (an & 1);
#pragma unroll
                for (int m = 0; m < 2; ++m)
#pragma unroll
                    for (int bj = 0; bj < 2; ++bj) ob[m][bj] = *(const u32x4*)(OR + (size_t)(row0 + ain * HALF + (mn + m) * 16) * RVW + col0 + bj * HALF); }
#pragma unroll
            for (int mm = 0; mm < 2; ++mm) { const int m = m0 + mm; const int r = ai * HALF + wr * 64 + m * 16 + fr; const float mean = sb[2 * r], rstd = sb[2 * r + 1];
                const size_t roff = (size_t)(row0 + ai * HALF + m * 16) * RVW + col0;
#pragma unroll
                for (int bj = 0; bj < 2; ++bj) { const u32x4 ov = oc[mm][bj];
                    const float ox[8] = {bf_lo(ov.x), bf_hi(ov.x), bf_lo(ov.y), bf_hi(ov.y), bf_lo(ov.z), bf_hi(ov.z), bf_lo(ov.w), bf_hi(ov.w)}; float a2[8];
#pragma unroll
                    for (int n = 0; n < 2; ++n)
#pragma unroll
                        for (int jx = 0; jx < 4; ++jx) { const float g = acc[ai][bj][m][n][jx]; const float sg = g * fast_rcp(1.f + fast_exp2(-1.4426950408889634f * g));
                            a2[4 * n + jx] = sg * ((ox[4 * n + jx] - mean) * rstd * gv[bj][n][jx]); }
                    u32x4 w; w.x = cvt_pk_bf16(a2[0], a2[1]); w.y = cvt_pk_bf16(a2[2], a2[3]); w.z = cvt_pk_bf16(a2[4], a2[5]); w.w = cvt_pk_bf16(a2[6], a2[7]);
                    *(u32x4*)(OW + roff + bj * HALF) = w; } } }
    }
};
struct EpiZ {
    static constexpr bool PERM = true; static constexpr bool WIDE = false; static constexpr bool ACC_BIAS = false;
    bf16_t* Y; const float* bias; const float* gate;
    __device__ __forceinline__ void operator()(const f32x4 (&acc)[2][2][4][2], const Unit& u, int wr, int wc, int fr, int fq) const {
        const int row0 = u.pm * BM + wr * 64 + fr, col0 = u.pn * BM + wc * 32 + 8 * fq; const float* gp = gate + (size_t)(u.pm >> 4) * 6 * D;
        f32x4 bv[2][2], gv[2][2];
#pragma unroll
        for (int bj = 0; bj < 2; ++bj)
#pragma unroll
            for (int n = 0; n < 2; ++n) { if (bias) bv[bj][n] = *(const f32x4*)(bias + col0 + bj * HALF + 4 * n); else bv[bj][n] = zero4(); gv[bj][n] = *(const f32x4*)(gp + col0 + bj * HALF + 4 * n) + 1.0f; }
#pragma unroll
        for (int ai = 0; ai < 2; ++ai)
#pragma unroll
            for (int m = 0; m < 4; ++m) { bf16_t* rowp = Y + (size_t)(row0 + ai * HALF + m * 16) * D + col0;
#pragma unroll
                for (int bj = 0; bj < 2; ++bj) { const f32x4 v0 = gv[bj][0] * (acc[ai][bj][m][0] + bv[bj][0]), v1 = gv[bj][1] * (acc[ai][bj][m][1] + bv[bj][1]);
                    u32x4 w; w.x = cvt_pk_bf16(v0[0], v0[1]); w.y = cvt_pk_bf16(v0[2], v0[3]); w.z = cvt_pk_bf16(v1[0], v1[1]); w.w = cvt_pk_bf16(v1[2], v1[3]);
                    *(u32x4*)(rowp + bj * HALF) = w; } }
    }
};
struct EpiGU {
    static constexpr bool PERM = true; static constexpr bool WIDE = false; static constexpr bool ACC_BIAS = false;
    bf16_t* H; const float* bgu;
    __device__ __forceinline__ void operator()(const f32x4 (&acc)[2][2][4][2], const Unit& u, int wr, int wc, int fr, int fq) const {
        const int row0 = u.pm * BM + wr * 64 + fr, fcol = u.pn * 128 + wc * 32 + 8 * fq; const float* bp = bgu + u.e * GUW;
        f32x4 bg[2], bu[2];
#pragma unroll
        for (int n = 0; n < 2; ++n) { bg[n] = *(const f32x4*)(bp + fcol + 4 * n); bu[n] = *(const f32x4*)(bp + EFF + fcol + 4 * n); }
#pragma unroll
        for (int ai = 0; ai < 2; ++ai)
#pragma unroll
            for (int m = 0; m < 4; ++m) { const int row = row0 + ai * HALF + m * 16; float o[8];
#pragma unroll
                for (int n = 0; n < 2; ++n) { const f32x4 g4 = acc[ai][0][m][n] + bg[n], u4 = acc[ai][1][m][n] + bu[n];
#pragma unroll
                    for (int j = 0; j < 4; ++j) { const float g = fminf(g4[j], 7.0f), up = fminf(fmaxf(u4[j], -7.0f), 7.0f);
                        o[4 * n + j] = (up + 1.0f) * g * fast_rcp(1.0f + fast_exp2(-1.702f * 1.4426950408889634f * g)); } }
                u32x4 w; w.x = cvt_pk_bf16(o[0], o[1]); w.y = cvt_pk_bf16(o[2], o[3]); w.z = cvt_pk_bf16(o[4], o[5]); w.w = cvt_pk_bf16(o[6], o[7]);
                *(u32x4*)(H + (size_t)row * EFF + fcol) = w; }
    }
};
struct EpiDown {
    static constexpr bool PERM = true; static constexpr bool WIDE = true; static constexpr bool ACC_BIAS = true;
    unsigned char* Y; const float* bdn;
    __device__ __forceinline__ void bias_load(const Unit& u, int wc, int fq, f32x4 (&bv)[2][2]) const {
        const float* bp = bdn + (size_t)u.e * D + u.pn * BM + wc * 64 + 16 * fq;
#pragma unroll
        for (int bj = 0; bj < 2; ++bj)
#pragma unroll
            for (int n = 0; n < 2; ++n) bv[bj][n] = *(const f32x4*)(bp + 8 * bj + 4 * n);
    }
    __device__ __forceinline__ void bias_load_untracked(const Unit& u, int wc, int fq, f32x4 (&bv)[2][2]) const {
        const float* bp = bdn + (size_t)u.e * D + u.pn * BM + wc * 64 + 16 * fq;
        asm volatile("global_load_dwordx4 %0, %4, off\n\tglobal_load_dwordx4 %1, %4, off offset:16\n\tglobal_load_dwordx4 %2, %4, off offset:32\n\tglobal_load_dwordx4 %3, %4, off offset:48"
                     : "=&v"(bv[0][0]), "=&v"(bv[0][1]), "=&v"(bv[1][0]), "=&v"(bv[1][1]) : "v"(bp) : "memory");
    }
    static constexpr int NSTORE = 8;
    __device__ __forceinline__ void operator()(const f32x4 (&acc)[2][2][4][2], const Unit& u, int wr, int wc, int fr, int fq) const {
        const int row0 = u.pm * BM + wr * 64 + fr, col0 = u.pn * BM + wc * 64 + 16 * fq;
#pragma unroll
        for (int ai = 0; ai < 2; ++ai)
#pragma unroll
            for (int m = 0; m < 4; ++m) { unsigned char* rowp = Y + (size_t)(row0 + ai * HALF + m * 16) * D + col0;
                int w[4];
#pragma unroll
                for (int bj = 0; bj < 2; ++bj) { f32x4 v0 = acc[ai][bj][m][0] * YP_SCALE, v1 = acc[ai][bj][m][1] * YP_SCALE;
#pragma unroll
                    for (int jx = 0; jx < 4; ++jx) { v0[jx] = __builtin_amdgcn_fmed3f(v0[jx], -448.0f, 448.0f); v1[jx] = __builtin_amdgcn_fmed3f(v1[jx], -448.0f, 448.0f); }
                    int w0 = 0, w1 = 0; w0 = __builtin_amdgcn_cvt_pk_fp8_f32(v0[0], v0[1], w0, false); w0 = __builtin_amdgcn_cvt_pk_fp8_f32(v0[2], v0[3], w0, true);
                    w1 = __builtin_amdgcn_cvt_pk_fp8_f32(v1[0], v1[1], w1, false); w1 = __builtin_amdgcn_cvt_pk_fp8_f32(v1[2], v1[3], w1, true);
                    w[2 * bj] = w0; w[2 * bj + 1] = w1; }
                *(u32x4*)rowp = (u32x4){(unsigned)w[0], (unsigned)w[1], (unsigned)w[2], (unsigned)w[3]}; }
    }
};
struct GuOrder {
    static constexpr bool SKIP = true;
    int G, c, L0, L1; const LAS int* ts; const LAS int* cn; const int* rows; const bf16_t* U; const bf16_t* W;
    __device__ __forceinline__ bool next(int i, Unit& u) const {
        const int L = L0 + i * G + c; if (L >= L1) return false;
        const int tg = (__builtin_amdgcn_readfirstlane(ts[480 + (L >> 1)]) >> 20) & 255, e = __builtin_amdgcn_readfirstlane(ts[480 + tg]) & 255, rt = tg - __builtin_amdgcn_readfirstlane(ts[e]);
        const int left = __builtin_amdgcn_readfirstlane(cn[e]) - rt * BM;
        u = Unit{tg, L & 1, e, rt, left < BM ? left : BM, i}; return true;
    }
    __device__ __forceinline__ const char* a_base(const Unit&) const { return (const char*)U; }
    __device__ __forceinline__ const char* b_base(const Unit& u) const { return (const char*)W + ((size_t)(u.e * GUW + u.pn * BM)) * D * 2; }
    __device__ __forceinline__ int row_token(const Unit& u, int r) const { return rows[u.e * ECAP + (r < u.valid ? u.rt * BM + r : 0)]; }
};
struct DownOrder {
    static constexpr bool SKIP = true;
    int G, c, D0, D1, nlate; const LAS int* ts; const LAS int* cn; const bf16_t* Hb; const bf16_t* W;
    static constexpr int PRE = 7;
    __device__ __forceinline__ bool next(int i, Unit& u) const {
        const int NL = G - nlate; int L;
        if (c < nlate) L = D0 + PRE * NL + i * G + c;
        else L = D0 + (i < PRE ? i * NL + (c - nlate) : PRE * NL + (i - PRE) * G + c);
        if (nlate == 0) L = D0 + i * G + c;
        if (L >= D1) return false;
        const int tg = (__builtin_amdgcn_readfirstlane(ts[480 + (L >> 4)]) >> 20) & 255, e = __builtin_amdgcn_readfirstlane(ts[480 + tg]) & 255, rt = tg - __builtin_amdgcn_readfirstlane(ts[e]);
        const int left = __builtin_amdgcn_readfirstlane(cn[e]) - rt * BM;
        u = Unit{tg, L & 15, e, rt, left < BM ? left : BM, i}; return true;
    }
    __device__ __forceinline__ const char* a_base(const Unit& u) const { return (const char*)Hb + (size_t)u.pm * BM * EFF * 2; }
    __device__ __forceinline__ const char* b_base(const Unit& u) const { return (const char*)W + ((size_t)u.e * D + u.pn * BM) * EFF * 2; }
    __device__ __forceinline__ int row_token(const Unit&, int r) const { return r; }
};
}

#define XB_TMO      128
#define XB_XCNT(j)  (256  + 64 * (j))
#define XB_XSUB(j)  (1280 + 64 * (j))
#define XB_XGEN(j)  (2304 + 64 * (j))
#define XB_TOP      3328
#define XB_TOPGEN   3392
#define XCD_BAR_WORDS 3456
#define XB_SPIN_CAP (1u << 18)
__device__ __forceinline__ unsigned xb_ld(unsigned* p)              { return __hip_atomic_load(p, __ATOMIC_RELAXED, __HIP_MEMORY_SCOPE_AGENT); }
__device__ __forceinline__ unsigned xb_add(unsigned* p, unsigned v) { return __hip_atomic_fetch_add(p, v, __ATOMIC_RELAXED, __HIP_MEMORY_SCOPE_AGENT); }
__device__ __forceinline__ unsigned xb_xcc_id() { return (unsigned)__builtin_amdgcn_s_getreg((3 << 11) | 20) & 0xFu; }
#define XB_SPIN(cond, bar) do { unsigned _sp = 0; while (cond) { __builtin_amdgcn_s_sleep(1); \
    if ((++_sp & 255u) == 0u) { if (xb_ld(&(bar)[XB_TMO])) break; if (_sp > XB_SPIN_CAP) { atomicAdd(&(bar)[XB_TMO], 1u); break; } } } } while (0)
struct XcdBarrier { unsigned* bar; unsigned x; volatile LAS unsigned* st; };
__device__ __forceinline__ XcdBarrier xcd_barrier_post(unsigned* bar, volatile LAS unsigned* st) {
    XcdBarrier b; b.bar = bar; b.x = xb_xcc_id(); b.st = st;
    if (threadIdx.x == 0) (void)xb_add(&bar[XB_XCNT(b.x)], 1u);
    return b;
}
__device__ __forceinline__ void xcd_barrier_complete(unsigned* bar, unsigned x, unsigned& nloc, unsigned& nx) {
    const unsigned G = gridDim.x * gridDim.y * gridDim.z;
    unsigned sum, cnt, mine, sp = 0u;
    for (;;) {
        sum = 0u; cnt = 0u; mine = 0u;
#pragma unroll
        for (unsigned j = 0; j < 16; ++j) { const unsigned c = xb_ld(&bar[XB_XCNT(j)]); sum += c; cnt += (c > 0u) ? 1u : 0u; mine = (j == x) ? c : mine; }
        if (sum == G) break;
        __builtin_amdgcn_s_sleep(1);
        if ((++sp & 255u) == 0u) { if (xb_ld(&bar[XB_TMO])) break; if (sp > XB_SPIN_CAP) { atomicAdd(&bar[XB_TMO], 1u); break; } }
    }
    nloc = mine > 0u ? mine : 1u; nx = cnt > 0u ? cnt : 1u;
}
__device__ __forceinline__ void xcd_barrier(const XcdBarrier& b, const int tid) {
    asm volatile("s_waitcnt vmcnt(0)" ::: "memory");
    __syncthreads();
    if (tid == 0) {
        unsigned* bar = b.bar;
        __builtin_amdgcn_s_waitcnt(0);
        unsigned nloc = b.st[0], nx = b.st[1];
        if (nloc == 0u) { xcd_barrier_complete(bar, b.x, nloc, nx); b.st[0] = nloc; b.st[1] = nx; }
        const unsigned old = xb_add(&bar[XB_XSUB(b.x)], 1u);
        const unsigned gen = old / nloc;
        if (old + 1u == (gen + 1u) * nloc) {
            __builtin_amdgcn_fence(__ATOMIC_RELEASE, "agent");
            asm volatile("s_waitcnt vmcnt(0)" ::: "memory");
            const unsigned og = xb_add(&bar[XB_TOP], 1u);
            const unsigned tg = og / nx;
            if (og + 1u == (tg + 1u) * nx) xb_add(&bar[XB_TOPGEN], 1u);
            else XB_SPIN(xb_ld(&bar[XB_TOPGEN]) == tg, bar);
            __builtin_amdgcn_fence(__ATOMIC_ACQUIRE, "agent");
            xb_add(&bar[XB_XGEN(b.x)], 1u);
            asm volatile("s_waitcnt vmcnt(0)" ::: "memory");
        } else {
            XB_SPIN(xb_ld(&bar[XB_XGEN(b.x)]) == gen, bar);
            __builtin_amdgcn_fence(__ATOMIC_ACQUIRE, "agent");
            asm volatile("s_waitcnt vmcnt(0)" ::: "memory");
        }
    }
    __syncthreads();
}

struct Args {
    const float* x; const float* c; const int* pos; const float* mod_w; const float* mod_b; const float* mod_layer; const float* ln_gain; const float* ln_bias;
    const float* w_qkv; const float* b_qkv; const float* sinks; const float* w_oa; const float* b_oa; const float* w_ret; const float* gn_gain; const float* w_or;
    const float* router_w; const float* router_b; const float* w_gu; const float* b_gu; const float* w_dn; const float* b_dn;
    float* out; unsigned char* ws; int ph_lo, ph_hi, use_bar, k_dn;
};
typedef const __attribute__((address_space(4))) Args CArgs;

__device__ __forceinline__ void transpose_item(const float* W, int K, int N, bf16_t* WT, int kb, int n0s, int n0d, bool rp, LAS float* scr, int lane) {
    const int k0 = 64 * kb;
    f32x4 tv[8];
#pragma unroll
    for (int i = 0; i < 8; ++i) tv[i] = __builtin_nontemporal_load((const f32x4*)(W + (size_t)(k0 + 8 * i + (lane >> 3)) * N + n0s + 4 * (lane & 7)));
#pragma unroll
    for (int i = 0; i < 8; ++i) { LAS float* d = scr + (8 * i + (lane >> 3)) * 33 + 4 * (lane & 7); d[0] = tv[i][0]; d[1] = tv[i][1]; d[2] = tv[i][2]; d[3] = tv[i][3]; }
    asm volatile("s_waitcnt lgkmcnt(0)" ::: "memory");
    const int cch = lane & 7;
#pragma unroll
    for (int j = 0; j < 4; ++j) { const int n = (lane >> 3) + 8 * j; int ns = n;
        if (rp && n < 16) ns = (n & 3) | ((n & 4) << 1) | ((n & 8) >> 1);
        const LAS float* s = scr + (8 * cch) * 33 + ns;
        u32x4 o; o.x = cvt_pk_bf16(s[0 * 33], s[1 * 33]); o.y = cvt_pk_bf16(s[2 * 33], s[3 * 33]); o.z = cvt_pk_bf16(s[4 * 33], s[5 * 33]); o.w = cvt_pk_bf16(s[6 * 33], s[7 * 33]);
        __builtin_nontemporal_store(o, (u32x4*)(WT + (size_t)(n0d + n) * K + k0 + 8 * cch)); }
    asm volatile("s_waitcnt lgkmcnt(0)" ::: "memory");
}
__device__ __forceinline__ float silu_f(float v) { return v / (1.0f + __expf(-v)); }

__device__ __forceinline__ void prep_items(CArgs& a, LAS unsigned char* lds, int wave, int lane, int worker, int nworkers, int mode) {
    bf16_t* Wb = (bf16_t*)(a.ws + WS_W);
    LAS float* scr = (LAS float*)(lds + wave * 16384);
    constexpr int I_QKV = 64 * 160, I_OA = 64 * 128, I_RET = 64 * 768, I_OR = 128 * 128, I_GU = 64 * 16, I_DN = 4 * 128;
    constexpr int E_QKV = 2 * I_QKV, E_OA = E_QKV + 2 * I_OA, E_RET = E_OA + 2 * I_RET, E_OR = E_RET + 2 * I_OR, E_GU = E_OR + 128 * I_GU, E_DN = E_GU + 128 * I_DN;
    constexpr int SIDE = 8192;
    const int nq = mode == 0 ? E_DN : SIDE;
    for (int q0 = worker; q0 < nq; q0 += nworkers) {
        int it = q0;
        if (mode == 0) { if ((it >= E_QKV + I_OA && it < E_QKV + I_OA + SIDE) || (it >= E_RET + I_OR && it < E_RET + I_OR + SIDE)) continue; }
        else if (mode == 1) it = E_QKV + I_OA + q0;
        else it = E_RET + I_OR + q0;
        if (it < E_QKV) { const int j = it / I_QKV, r = it % I_QKV, kb = r / 160, nb = r % 160; const int n0 = 32 * nb;
            transpose_item(a.w_qkv + (size_t)j * D * QKVN, D, QKVN, Wb + (W_QKV / 2) + (size_t)j * QKVN * D, kb, n0, n0, (n0 < 4608) && ((n0 & 63) == 0), scr, lane); }
        else if (it < E_OA) { const int q = it - E_QKV, j = q / I_OA, r = q % I_OA, kb = r / 128, nb = r % 128;
            transpose_item(a.w_oa + (size_t)j * D * D, D, D, Wb + (W_OA / 2) + (size_t)j * D * D, kb, 32 * nb, 32 * nb, false, scr, lane); }
        else if (it < E_RET) { const int q = it - E_OA, j = q / I_RET, r = q % I_RET, kb = r / 768, nb = r % 768;
            transpose_item(a.w_ret + (size_t)j * D * RETN, D, RETN, Wb + (W_RET / 2) + (size_t)j * RETN * D, kb, 32 * nb, 32 * nb, false, scr, lane); }
        else if (it < E_OR) { const int q = it - E_RET, j = q / I_OR, r = q % I_OR, kb = r / 128, nb = r % 128;
            transpose_item(a.w_or + (size_t)j * RVW * D, RVW, D, Wb + (W_OR / 2) + (size_t)j * D * RVW, kb, 32 * nb, 32 * nb, false, scr, lane); }
        else if (it < E_GU) { const int q = it - E_OR, mi = q / I_GU, r = q % I_GU, kb = r / 16, nb = r % 16;
            const int rowd = 32 * nb, tt = rowd >> 8, p = rowd & 255, bj = p >> 7, qq = p & 127; const int cols = bj * 256 + tt * 128 + qq;
            transpose_item(a.w_gu + (size_t)mi * D * GUW, D, GUW, Wb + (W_GU / 2) + (size_t)mi * GUW * D, kb, cols, rowd, false, scr, lane); }
        else { const int q = it - E_GU, mi = q / I_DN, r = q % I_DN, kb = r / 128, nb = r % 128;
            transpose_item(a.w_dn + (size_t)mi * EFF * D, EFF, D, Wb + (W_DN / 2) + (size_t)mi * D * EFF, kb, 32 * nb, 32 * nb, false, scr, lane); }
    }
}

__device__ __forceinline__ void phase_prep(CArgs& a, LAS unsigned char* lds, int G, int c, int wv) {
    const int tid = opaque_tid(wv), lane = tid & 63, wave = __builtin_amdgcn_readfirstlane(tid >> 6);
    const int gw = c * 8 + wave, NGW = G * 8;
    unsigned char* ws = a.ws;
    { float* modp = (float*)(ws + WS_MODP);
      for (int task = gw; task < 96 * 32; task += NGW) { const int cg = task % 96, kp = task / 96; const int col = cg * 256 + 4 * lane;
          f32x4 a0 = zero4(), a1 = zero4();
#pragma unroll 8
          for (int kk = 0; kk < 128; ++kk) { const int k = kp * 128 + kk; const f32x4 w = *(const f32x4*)(a.mod_w + (size_t)k * 24576 + col);
              const float s0 = silu_f(a.c[k]), s1 = silu_f(a.c[D + k]); a0 += w * s0; a1 += w * s1; }
          *(f32x4*)(modp + ((size_t)kp * 2 + 0) * 24576 + col) = a0; *(f32x4*)(modp + ((size_t)kp * 2 + 1) * 24576 + col) = a1; } }
    { const int gt = gw * 64 + lane, NT = NGW * 64;
      float* cosA = (float*)(ws + WS_CSA); float* sinA = cosA + T * 8; float* csR = (float*)(ws + WS_CSR); float* bq = (float*)(ws + WS_BQKV);
      for (int i = gt; i < T * 8; i += NT) { const int tok = i >> 3, f = i & 7; const float inv = powf(500000.0f, -(float)(2 * f) / 16.0f); const float ang = (float)a.pos[tok] * inv; cosA[i] = cosf(ang); sinA[i] = sinf(ang); }
      for (int i = gt; i < T * 128; i += NT) { const int tok = i >> 7, f = i & 127; const float inv = powf(10000.0f, -((float)f / 127.0f)); const float ang = (float)a.pos[tok] * inv; csR[2 * (size_t)i] = cosf(ang); csR[2 * (size_t)i + 1] = sinf(ang); }
      for (int i = gt; i < 2 * QKVN; i += NT) { const int j = i / QKVN, n = i % QKVN; int ns = n; const int p = n & 63;
          if (n < 4608 && p < 16) ns = (n & ~15) | (p & 3) | ((p & 4) << 1) | ((p & 8) >> 1);
          bq[i] = a.b_qkv[j * QKVN + ns]; } }
    prep_items(a, lds, wave, lane, gw, NGW, 0);
}
__device__ __forceinline__ void phase_modreduce(CArgs& a, int G, int c, int wv) {
    const float* modp = (const float*)(a.ws + WS_MODP); float* modL = (float*)(a.ws + WS_MODL);
    const int tid = opaque_tid(wv);
    for (int o = c * 512 + tid; o < 2 * 24576; o += G * 512) { const int b = o / 24576, col = o % 24576; float s = a.mod_b[col];
        for (int kp = 0; kp < 32; ++kp) s += modp[((size_t)kp * 2 + b) * 24576 + col];
#pragma unroll
        for (int l = 0; l < NLAYER; ++l) modL[((size_t)l * 2 + b) * 24576 + col] = s + a.mod_layer[(size_t)l * 24576 + col]; }
}
__device__ __forceinline__ void store_u_row(const f32x4 (&xv)[16], const float* shift, const float* scale, bf16_t* urow, int lane) {
#pragma unroll
    for (int jj = 0; jj < 16; ++jj) { const int col = 256 * jj + 4 * lane; const f32x4 sc = *(const f32x4*)(scale + col) + 1.0f, sh = *(const f32x4*)(shift + col);
        const f32x4 u = xv[jj] * sc + sh; u32x2 w; w.x = cvt_pk_bf16(u[0], u[1]); w.y = cvt_pk_bf16(u[2], u[3]); *(u32x2*)(urow + col) = w; }
}
__device__ __forceinline__ void phase_u0(CArgs& a, LAS unsigned char* lds, int G, int c, int wv) {
    const int tid = opaque_tid(wv), lane = tid & 63, wave = __builtin_amdgcn_readfirstlane(tid >> 6); const float* modL = (const float*)(a.ws + WS_MODL); bf16_t* U = (bf16_t*)(a.ws + WS_U);
    LAS float* TL = (LAS float*)lds;
    { f32x4 tvv[8];
#pragma unroll
      for (int i = 0; i < 8; ++i) { const int t = i >> 1, col = (i & 1) * 2048 + tid * 4; tvv[i] = (t < 2) ? *(const f32x4*)(modL + (size_t)t * 24576 + col) : *(const f32x4*)(modL + (size_t)(t - 2) * 24576 + D + col); }
#pragma unroll
      for (int i = 0; i < 8; ++i) { const int t = i >> 1, col = (i & 1) * 2048 + tid * 4; *(LAS f32x4*)(TL + t * D + col) = (t < 2) ? tvv[i] : tvv[i] + 1.0f; } }
    __syncthreads();
    for (int row = c * 8 + wave; row < T; row += G * 8) { const int b = row >> 12;
        f32x4 xv[16];
#pragma unroll
        for (int jj = 0; jj < 16; ++jj) xv[jj] = *(const f32x4*)(a.x + (size_t)row * D + 256 * jj + 4 * lane);
        unsigned so = (unsigned)(uintptr_t)(TL + b * D), co = (unsigned)(uintptr_t)(TL + (2 + b) * D); OPAQUE_S(so); OPAQUE_S(co);
        const LAS float* sp = (const LAS float*)(uintptr_t)so; const LAS float* cp = (const LAS float*)(uintptr_t)co; bf16_t* urow = U + (size_t)row * D;
#pragma unroll
        for (int jj = 0; jj < 16; ++jj) { const int col = 256 * jj + 4 * lane; const f32x4 u = xv[jj] * *(const LAS f32x4*)(cp + col) + *(const LAS f32x4*)(sp + col);
            u32x2 w; w.x = cvt_pk_bf16(u[0], u[1]); w.y = cvt_pk_bf16(u[2], u[3]); *(u32x2*)(urow + col) = w;
            u32x2 xh; xh.x = cvt_pk_f16(xv[jj][0], xv[jj][1]); xh.y = cvt_pk_f16(xv[jj][2], xv[jj][3]); __builtin_nontemporal_store(xh, (u32x2*)((bf16_t*)(a.ws + WS_XB) + (size_t)row * D + col)); } }
}
template <bool C8> __device__ __forceinline__ int lncol(int jj, int lane) { return C8 ? 512 * (jj >> 1) + 8 * lane + 4 * (jj & 1) : 256 * jj + 4 * lane; }
template <bool C8 = false>
__device__ __forceinline__ void ln_row(f32x4 (&v)[16], const float* gain, const float* bias, int lane) {
    float s = 0.f;
#pragma unroll
    for (int jj = 0; jj < 16; ++jj) s += (v[jj][0] + v[jj][1]) + (v[jj][2] + v[jj][3]);
    const float mean = wave_sum(s, lane) * (1.0f / D); float q = 0.f;
#pragma unroll
    for (int jj = 0; jj < 16; ++jj) { v[jj] = v[jj] - mean; q += (v[jj][0] * v[jj][0] + v[jj][1] * v[jj][1]) + (v[jj][2] * v[jj][2] + v[jj][3] * v[jj][3]); }
    const float rstd = 1.0f / sqrtf(wave_sum(q, lane) * (1.0f / D) + LN_EPS);
#pragma unroll
    for (int jj = 0; jj < 16; ++jj) { const int col = lncol<C8>(jj, lane); v[jj] = v[jj] * rstd * *(const f32x4*)(gain + col) + *(const f32x4*)(bias + col); }
}
template <bool C8 = false>
__device__ __forceinline__ void ln_row_lds(f32x4 (&v)[16], const LAS float* gain, const LAS float* bias, int lane) {
    unsigned go = (unsigned)(uintptr_t)gain, bo = (unsigned)(uintptr_t)bias; OPAQUE_S(go); OPAQUE_S(bo);
    const LAS float* gp = (const LAS float*)(uintptr_t)go; const LAS float* bp = (const LAS float*)(uintptr_t)bo;
    float s = 0.f;
#pragma unroll
    for (int jj = 0; jj < 16; ++jj) s += (v[jj][0] + v[jj][1]) + (v[jj][2] + v[jj][3]);
    const float mean = wave_sum(s, lane) * (1.0f / D); float q = 0.f;
#pragma unroll
    for (int jj = 0; jj < 16; ++jj) { v[jj] = v[jj] - mean; q += (v[jj][0] * v[jj][0] + v[jj][1] * v[jj][1]) + (v[jj][2] * v[jj][2] + v[jj][3] * v[jj][3]); }
    const float rstd = 1.0f / sqrtf(wave_sum(q, lane) * (1.0f / D) + LN_EPS);
#pragma unroll
    for (int jj = 0; jj < 16; ++jj) { const int col = lncol<C8>(jj, lane); v[jj] = v[jj] * rstd * *(const LAS f32x4*)(gp + col) + *(const LAS f32x4*)(bp + col); }
}
__device__ __forceinline__ void phase_ln1(CArgs& a, LAS unsigned char* lds, int layer, int G, int c, int wv, bool dry) {
    const bf16_t* Xb = (const bf16_t*)(a.ws + WS_XB); bf16_t* Xw = (bf16_t*)(a.ws + WS_XB);
    const int tid = opaque_tid(wv), lane = tid & 63, wave = __builtin_amdgcn_readfirstlane(tid >> 6);
    const bf16_t* Yp = (const bf16_t*)(a.ws + WS_Z); bf16_t* U = (bf16_t*)(a.ws + WS_U); const float* modL = (const float*)(a.ws + WS_MODL) + (size_t)layer * 2 * 24576;
    const float* gain = a.ln_gain + ((size_t)layer * 2 + 0) * D; const float* bias = a.ln_bias + ((size_t)layer * 2 + 0) * D;
    const float* rw = a.router_w + (size_t)layer * D * NEXP; const float* rb = a.router_b + layer * NEXP;
    unsigned* cnt = (unsigned*)(a.ws + WS_CTL) + CW_CNT + layer * 64;
    int* rows = (int*)(a.ws + WS_ROWS); int* tk_e = (int*)(a.ws + WS_TK); int* tk_pos = tk_e + T * 4; float* tk_w = (float*)(tk_pos + T * 4);
    constexpr int UP = 4352;
    LAS float* uL = (LAS float*)lds;
    LAS float* pL = (LAS float*)(lds + 8 * UP * 4);
    LAS float* lg = (LAS float*)(lds + 8 * UP * 4 + 8192);
    const float rbv = rb[tid & 31];
    if (!dry && ((c >> 3) & 1)) { __builtin_amdgcn_s_sleep(127); __builtin_amdgcn_s_sleep(127); }
    u32x4 yq[8], xq[8];
    { const int row = c * 8 + wave;
#pragma unroll
      for (int p = 0; p < 8; ++p) yq[p] = __builtin_nontemporal_load((const u32x4*)(Yp + (size_t)row * D + 512 * p + 8 * lane));
#pragma unroll
      for (int p = 0; p < 8; ++p) xq[p] = __builtin_nontemporal_load((const u32x4*)(Xb + (size_t)row * D + 512 * p + 8 * lane)); }
    for (int it = c; it < T / 8; it += G) {
        const int row = it * 8 + wave, b = row >> 12; const float* mb = modL + (size_t)b * 24576;
        f32x4 v[16];
        f32x4 tA[16], tB[16];
        typedef const __attribute__((address_space(1))) float* gfp_t; typedef const __attribute__((address_space(1))) f32x4* gf4p_t;
        typedef const __attribute__((address_space(1))) char* gcp_t; const unsigned tvo = 32u * (unsigned)lane;
        gcp_t tgp = (gcp_t)gain, tbp = (gcp_t)bias, tcp = (gcp_t)(mb + 4 * D), thp = (gcp_t)(mb + 3 * D);
#define LN1_TLOAD(t, hb) { gcp_t g_ = tgp + 4096 * (hb), b_ = tbp + 4096 * (hb), c_ = tcp + 4096 * (hb), h_ = thp + 4096 * (hb); OPAQUE_S(g_); OPAQUE_S(b_); OPAQUE_S(c_); OPAQUE_S(h_); \
            _Pragma("unroll") for (int q = 0; q < 4; ++q) { const int off = 2048 * (q >> 1) + 16 * (q & 1); \
            t[q] = *(gf4p_t)(g_ + (size_t)tvo + off); t[4 + q] = *(gf4p_t)(b_ + (size_t)tvo + off); t[8 + q] = *(gf4p_t)(c_ + (size_t)tvo + off); t[12 + q] = *(gf4p_t)(h_ + (size_t)tvo + off); } }
#define LN1_TUSE(t, hb) { _Pragma("unroll") for (int pp = 0; pp < 2; ++pp) { const int p = 2 * (hb) + pp, col = 512 * p + 8 * lane; \
            const f32x4 x0 = v[2 * p] * rstd * t[2 * pp] + t[4 + 2 * pp], x1 = v[2 * p + 1] * rstd * t[2 * pp + 1] + t[4 + 2 * pp + 1]; \
            u32x4 wx; wx.x = cvt_pk_f16(x0[0], x0[1]); wx.y = cvt_pk_f16(x0[2], x0[3]); wx.z = cvt_pk_f16(x1[0], x1[1]); wx.w = cvt_pk_f16(x1[2], x1[3]); \
            *(u32x4*)((dry ? (bf16_t*)(a.ws + WS_ACT + ACT_SG) : Xw) + (size_t)row * D + col) = wx; \
            const f32x4 u0 = x0 * (t[8 + 2 * pp] + 1.0f) + t[12 + 2 * pp], u1 = x1 * (t[8 + 2 * pp + 1] + 1.0f) + t[12 + 2 * pp + 1]; \
            u32x4 w; w.x = cvt_pk_bf16(u0[0], u0[1]); w.y = cvt_pk_bf16(u0[2], u0[3]); w.z = cvt_pk_bf16(u1[0], u1[1]); w.w = cvt_pk_bf16(u1[2], u1[3]); *(u32x4*)(U + (size_t)row * D + col) = w; \
            *(LAS f32x4*)(uL + wave * UP + col + 4 * (col >> 6)) = u0; *(LAS f32x4*)(uL + wave * UP + col + 4 + 4 * (col >> 6)) = u1; } }
        LN1_TLOAD(tA, 0)
        __builtin_amdgcn_sched_barrier(0);
#pragma unroll
        for (int p = 0; p < 8; ++p) { v[2 * p] = (f32x4){h_lo(xq[p].x), h_hi(xq[p].x), h_lo(xq[p].y), h_hi(xq[p].y)}; v[2 * p + 1] = (f32x4){h_lo(xq[p].z), h_hi(xq[p].z), h_lo(xq[p].w), h_hi(xq[p].w)}; }
#pragma unroll
        for (int p = 0; p < 8; ++p) { v[2 * p] = v[2 * p] * ALPHA + (f32x4){bf_lo(yq[p].x), bf_hi(yq[p].x), bf_lo(yq[p].y), bf_hi(yq[p].y)}; v[2 * p + 1] = v[2 * p + 1] * ALPHA + (f32x4){bf_lo(yq[p].z), bf_hi(yq[p].z), bf_lo(yq[p].w), bf_hi(yq[p].w)}; }
        __builtin_amdgcn_sched_barrier(0); LN1_TLOAD(tB, 1) __builtin_amdgcn_sched_barrier(0);
        float rstd; { float s_ = 0.f;
#pragma unroll
            for (int jj = 0; jj < 16; ++jj) s_ += (v[jj][0] + v[jj][1]) + (v[jj][2] + v[jj][3]);
            const float mean = wave_sum(s_, lane) * (1.0f / D); float q_ = 0.f;
#pragma unroll
            for (int jj = 0; jj < 16; ++jj) { v[jj] = v[jj] - mean; q_ += (v[jj][0] * v[jj][0] + v[jj][1] * v[jj][1]) + (v[jj][2] * v[jj][2] + v[jj][3] * v[jj][3]); }
            rstd = 1.0f / sqrtf(wave_sum(q_, lane) * (1.0f / D) + LN_EPS); }
        const int eg = tid & 7, ks = tid >> 3; gcp_t wp = (gcp_t)rw; f32x4 wA[8], wB[8]; const unsigned wvo = (unsigned)((ks * 64 * NEXP + 4 * eg) * 4);
        gcp_t wph = wp + 32 * NEXP * 4; OPAQUE_S(wp); OPAQUE_S(wph);
#define LN1_WLOAD(w, g) { _Pragma("unroll") for (int i = 0; i < 8; ++i) w[i] = *(gf4p_t)(((g) < 4 ? wp : wph) + (size_t)wvo + (8 * ((g) & 3) + i) * NEXP * 4); }
        __builtin_amdgcn_sched_barrier(0);
        LN1_TUSE(tA, 0) __builtin_amdgcn_sched_barrier(0);
        LN1_TLOAD(tA, 2) __builtin_amdgcn_sched_barrier(0); LN1_TUSE(tB, 1) __builtin_amdgcn_sched_barrier(0);
        LN1_TLOAD(tB, 3) __builtin_amdgcn_sched_barrier(0); LN1_TUSE(tA, 2) __builtin_amdgcn_sched_barrier(0);
        LN1_WLOAD(wA, 0) __builtin_amdgcn_sched_barrier(0); LN1_TUSE(tB, 3) __builtin_amdgcn_sched_barrier(0);
        __syncthreads();
        { f32x4 acc[8];
#pragma unroll
          for (int r = 0; r < 8; ++r) acc[r] = zero4();
          const LAS float* up = uL + ks * 68;
#define LN1_WUSE(w, g) { _Pragma("unroll") for (int s4 = 0; s4 < 2; ++s4) { _Pragma("unroll") for (int r = 0; r < 8; ++r) { const f32x4 uv = *(const LAS f32x4*)(up + r * UP + 8 * (g) + 4 * s4); \
              acc[r] = w[4 * s4 + 0] * uv[0] + acc[r]; acc[r] = w[4 * s4 + 1] * uv[1] + acc[r]; acc[r] = w[4 * s4 + 2] * uv[2] + acc[r]; acc[r] = w[4 * s4 + 3] * uv[3] + acc[r]; } } }
          LN1_WLOAD(wB, 1) __builtin_amdgcn_sched_barrier(0); LN1_WUSE(wA, 0) __builtin_amdgcn_sched_barrier(0);
          LN1_WLOAD(wA, 2) __builtin_amdgcn_sched_barrier(0); LN1_WUSE(wB, 1) __builtin_amdgcn_sched_barrier(0);
          LN1_WLOAD(wB, 3) __builtin_amdgcn_sched_barrier(0); LN1_WUSE(wA, 2) __builtin_amdgcn_sched_barrier(0);
          LN1_WLOAD(wA, 4) __builtin_amdgcn_sched_barrier(0); LN1_WUSE(wB, 3) __builtin_amdgcn_sched_barrier(0);
          LN1_WLOAD(wB, 5) __builtin_amdgcn_sched_barrier(0); LN1_WUSE(wA, 4) __builtin_amdgcn_sched_barrier(0);
          LN1_WLOAD(wA, 6) __builtin_amdgcn_sched_barrier(0); LN1_WUSE(wB, 5) __builtin_amdgcn_sched_barrier(0);
          LN1_WLOAD(wB, 7) __builtin_amdgcn_sched_barrier(0); LN1_WUSE(wA, 6) __builtin_amdgcn_sched_barrier(0);
          LN1_WUSE(wB, 7)
#pragma unroll
          for (int r = 0; r < 8; ++r)
#pragma unroll
              for (int jx = 0; jx < 4; ++jx) { float t = acc[r][jx]; t += shx(t, 8, lane); t += shx(t, 16, lane); t += shx(t, 32, lane); acc[r][jx] = t; }
          if (lane < 8) {
#pragma unroll
              for (int r = 0; r < 8; ++r) *(LAS f32x4*)(pL + (wave * 8 + r) * NEXP + 4 * eg) = acc[r]; } }
        { const int itn = it + G < T / 8 ? it + G : it, rown = itn * 8 + wave;
#pragma unroll
            for (int p = 0; p < 8; ++p) yq[p] = __builtin_nontemporal_load((const u32x4*)(Yp + (size_t)rown * D + 512 * p + 8 * lane));
#pragma unroll
            for (int p = 0; p < 8; ++p) xq[p] = __builtin_nontemporal_load((const u32x4*)(Xb + (size_t)rown * D + 512 * p + 8 * lane)); }
        __syncthreads();
        if (tid < 256) { const int r = tid >> 5, e = tid & 31; float s = rbv;
#pragma unroll
            for (int wq = 0; wq < 8; ++wq) s += pL[(wq * 8 + r) * NEXP + e];
            lg[r * NEXP + e] = s; }
        __syncthreads();
        if (!dry) {
            const int tok = it * 8 + wave; float val = lg[wave * NEXP + (lane & 31)]; float tv = 0.f, t0 = 0.f; int te = 0;
#pragma unroll
            for (int k = 0; k < 4; ++k) { float bv = val; int bi = lane & 31;
#pragma unroll
                for (int o = 1; o < 32; o <<= 1) { const float ov = shx(bv, o, lane); const int oi = __builtin_amdgcn_ds_bpermute((lane ^ o) << 2, bi); if (ov > bv || (ov == bv && oi < bi)) { bv = ov; bi = oi; } }
                if (k == 0) t0 = bv; if (lane == k) { tv = bv; te = bi; } if ((lane & 31) == bi) val = -3.0e38f; }
            float ex = (lane < 4) ? __expf(tv - t0) : 0.f; float den = ex; den += shx(den, 1, lane); den += shx(den, 2, lane);
            if (lane < 4) { const unsigned p = atomicAdd(cnt + te, 1u); rows[te * ECAP + (int)p] = tok; tk_e[tok * 4 + lane] = te; tk_pos[tok * 4 + lane] = (int)p; tk_w[tok * 4 + lane] = ex / den; } }
        __syncthreads();
    }
}
__device__ __forceinline__ int moe_tables(CArgs& a, LAS unsigned char* lds, int layer, int wv, bool reuse) {
    LAS int* ts = (LAS int*)(lds + LDSCTL_OFF); LAS int* cn = ts + 64;
    if (reuse) return ts[NEXP];
    const unsigned* cnt = (const unsigned*)(a.ws + WS_CTL) + CW_CNT + layer * 64;
    const int tid = opaque_tid(wv);
    __syncthreads();
    if (tid < NEXP) cn[tid] = (int)__hip_atomic_load(cnt + tid, __ATOMIC_RELAXED, __HIP_MEMORY_SCOPE_AGENT);
    __syncthreads();
    if (tid == 0) { int acc = 0; for (int e = 0; e < NEXP; ++e) { ts[e] = acc; acc += (cn[e] + 255) >> 8; } ts[NEXP] = acc; }
    __syncthreads();
    const int ntile = ts[NEXP];
    if (tid < MAXSLOT / 256) { int e = 0;
#pragma clang loop vectorize(disable)
        for (int k = 0; k < NEXP; ++k) if (tid >= ts[k + 1]) e = k + 1;
        e = e < NEXP ? e : NEXP - 1; int left = cn[e] - (tid - ts[e]) * 256; left = left < 256 ? left : 256; if (tid >= ntile) left = 0;
        ts[480 + tid] = e | (left << 8); }
    __syncthreads();
    int rank = 0;
    if (tid < ntile) { const int mine = (ts[480 + tid] >> 8) & 511;
#pragma unroll 1
        for (int j0 = 0; j0 < MAXSLOT / 256; j0 += 16) { int vv[16];
#pragma unroll
            for (int j = 0; j < 16; ++j) vv[j] = ts[480 + j0 + j];
#pragma unroll
            for (int j = 0; j < 16; ++j) { const int vj = (vv[j] >> 8) & 511; rank += (vj > mine || (vj == mine && j0 + j < tid)) ? 1 : 0; } } }
    __syncthreads();
    if (tid < ntile) ts[480 + rank] |= tid << 20;
    __syncthreads();
    return ntile;
}
__device__ __forceinline__ void phase_ln2(CArgs& a, LAS unsigned char* lds, int layer, int G, int c, int wv, bool dry, bool reuse_tab) {
    const int tid = opaque_tid(wv), lane = tid & 63, wave = __builtin_amdgcn_readfirstlane(tid >> 6);
    (void)moe_tables(a, lds, layer, wv, reuse_tab);
    const LAS int* ts = (const LAS int*)(lds + LDSCTL_OFF);
    const unsigned char* YP = (const unsigned char*)(a.ws + WS_ACT + ACT_YP); bf16_t* U = (bf16_t*)(a.ws + WS_U);
    const float* modL = (const float*)(a.ws + WS_MODL) + (size_t)layer * 2 * 24576; const float* modN = (const float*)(a.ws + WS_MODL) + (size_t)(layer + 1) * 2 * 24576;
    const float* gain = a.ln_gain + ((size_t)layer * 2 + 1) * D; const float* bias = a.ln_bias + ((size_t)layer * 2 + 1) * D; const bf16_t* Xb = (const bf16_t*)(a.ws + WS_XB);
    const int* tk_e = (const int*)(a.ws + WS_TK); const int* tk_pos = tk_e + T * 4; const float* tk_w = (const float*)(tk_pos + T * 4);
    LAS float* TL = (LAS float*)lds;
    { f32x4 tvv[16]; const bool hn = layer + 1 < NLAYER;
#pragma unroll
      for (int i = 0; i < 16; ++i) { const int t = i >> 1, col = (i & 1) * 2048 + tid * 4; const float* src;
          if (t == 0) src = gain + col; else if (t == 1) src = bias + col; else if (t < 4) src = modL + (size_t)(t - 2) * 24576 + 5 * D + col;
          else if (t < 6) src = (hn ? modN : modL) + (size_t)(t - 4) * 24576 + 0 * D + col; else src = (hn ? modN : modL) + (size_t)(t - 6) * 24576 + 1 * D + col;
          tvv[i] = *(const f32x4*)src; }
#pragma unroll
      for (int i = 0; i < 16; ++i) { const int t = i >> 1, col = (i & 1) * 2048 + tid * 4; f32x4 val = tvv[i];
          if (t == 2 || t == 3 || t >= 6) val = val + 1.0f;
          *(LAS f32x4*)(TL + t * D + col) = val; } }
    __syncthreads();
    int4 te4n, tp4n; f32x4 tw4n;
    { const int row0 = c * 8 + wave; if (row0 < T) { te4n = *(const int4*)(tk_e + row0 * 4); tp4n = *(const int4*)(tk_pos + row0 * 4); tw4n = *(const f32x4*)(tk_w + row0 * 4); } }
    for (int row = c * 8 + wave; row < T; row += G * 8) { const int b = row >> 12;
        f32x4 v[16];
        const int4 te4 = te4n, tp4 = tp4n; const f32x4 tw4 = tw4n;
        { const int rn = row + G * 8; if (rn < T) { te4n = *(const int4*)(tk_e + rn * 4); tp4n = *(const int4*)(tk_pos + rn * 4); tw4n = *(const f32x4*)(tk_w + rn * 4); } }
        const int tes[4] = {te4.x, te4.y, te4.z, te4.w}, tps[4] = {tp4.x, tp4.y, tp4.z, tp4.w};
        u32x2 yv[4][8];
#pragma unroll
        for (int k = 0; k < 4; ++k) { const unsigned char* yr = YP + ((size_t)ts[tes[k]] * 256 + tps[k]) * D + 8 * lane;
#pragma unroll
            for (int p = 0; p < 8; ++p) yv[k][p] = __builtin_nontemporal_load((const u32x2*)(yr + 512 * p)); }
        const f32x4 tws = tw4 * (1.0f / YP_SCALE);
#pragma unroll
        for (int p = 0; p < 8; ++p) { f32x4 t0 = zero4(), t1 = t0;
#pragma unroll
            for (int k = 0; k < 4; ++k) { const f32x2 a0 = __builtin_amdgcn_cvt_pk_f32_fp8((int)yv[k][p].x, false), a1 = __builtin_amdgcn_cvt_pk_f32_fp8((int)yv[k][p].x, true), b0 = __builtin_amdgcn_cvt_pk_f32_fp8((int)yv[k][p].y, false), b1 = __builtin_amdgcn_cvt_pk_f32_fp8((int)yv[k][p].y, true);
                t0 += (f32x4){a0[0], a0[1], a1[0], a1[1]} * tws[k]; t1 += (f32x4){b0[0], b0[1], b1[0], b1[1]} * tws[k]; }
            v[2 * p] = t0; v[2 * p + 1] = t1; }
        { unsigned go = (unsigned)(uintptr_t)(TL + (2 + b) * D); OPAQUE_S(go); const LAS float* gp = (const LAS float*)(uintptr_t)go;
          u32x4 xqa[8];
#pragma unroll
          for (int p = 0; p < 8; ++p) xqa[p] = __builtin_nontemporal_load((const u32x4*)(Xb + (size_t)row * D + 512 * p + 8 * lane));
          asm volatile("" ::: "memory");
#pragma unroll
          for (int p = 0; p < 8; ++p) { const u32x4 xq = xqa[p];
              v[2 * p] = (f32x4){h_lo(xq.x), h_hi(xq.x), h_lo(xq.y), h_hi(xq.y)} * ALPHA + *(const LAS f32x4*)(gp + 512 * p + 8 * lane) * v[2 * p];
              v[2 * p + 1] = (f32x4){h_lo(xq.z), h_hi(xq.z), h_lo(xq.w), h_hi(xq.w)} * ALPHA + *(const LAS f32x4*)(gp + 512 * p + 8 * lane + 4) * v[2 * p + 1]; } }
        ln_row_lds<true>(v, TL, TL + D, lane);
        if (layer + 1 == NLAYER) { float* xo = dry ? (float*)(a.ws + WS_Z) : a.out;
#pragma unroll
            for (int jj = 0; jj < 16; ++jj) __builtin_nontemporal_store(v[jj], (f32x4*)(xo + (size_t)row * D + lncol<true>(jj, lane))); }
        else { bf16_t* xo = dry ? (bf16_t*)(a.ws + WS_Z) : (bf16_t*)(a.ws + WS_XB);
#pragma unroll
            for (int p = 0; p < 8; ++p) { u32x4 w; w.x = cvt_pk_f16(v[2 * p][0], v[2 * p][1]); w.y = cvt_pk_f16(v[2 * p][2], v[2 * p][3]); w.z = cvt_pk_f16(v[2 * p + 1][0], v[2 * p + 1][1]); w.w = cvt_pk_f16(v[2 * p + 1][2], v[2 * p + 1][3]);
                *(u32x4*)(xo + (size_t)row * D + 512 * p + 8 * lane) = w; } }
        if (layer + 1 < NLAYER) { unsigned so = (unsigned)(uintptr_t)(TL + (4 + b) * D), co = (unsigned)(uintptr_t)(TL + (6 + b) * D); OPAQUE_S(so); OPAQUE_S(co);
            const LAS float* sp = (const LAS float*)(uintptr_t)so; const LAS float* cp = (const LAS float*)(uintptr_t)co; bf16_t* urow = U + (size_t)row * D;
#pragma unroll
            for (int p = 0; p < 8; ++p) { const int col = 512 * p + 8 * lane; const f32x4 u0 = v[2 * p] * *(const LAS f32x4*)(cp + col) + *(const LAS f32x4*)(sp + col), u1 = v[2 * p + 1] * *(const LAS f32x4*)(cp + col + 4) + *(const LAS f32x4*)(sp + col + 4);
                u32x4 w; w.x = cvt_pk_bf16(u0[0], u0[1]); w.y = cvt_pk_bf16(u0[2], u0[3]); w.z = cvt_pk_bf16(u1[0], u1[1]); w.w = cvt_pk_bf16(u1[2], u1[3]); *(u32x4*)(urow + col) = w; } }
    }
}

template <int O0, int O1>
__device__ __forceinline__ void tr_read8(unsigned base, s16x4 (&lo)[4], s16x4 (&hi)[4]) {
    asm volatile("ds_read_b64_tr_b16 %0, %8 offset:%9\n\tds_read_b64_tr_b16 %1, %8 offset:%10\n\tds_read_b64_tr_b16 %2, %8 offset:%11\n\tds_read_b64_tr_b16 %3, %8 offset:%12\n\t"
                 "ds_read_b64_tr_b16 %4, %8 offset:%13\n\tds_read_b64_tr_b16 %5, %8 offset:%14\n\tds_read_b64_tr_b16 %6, %8 offset:%15\n\tds_read_b64_tr_b16 %7, %8 offset:%16\n\ts_waitcnt lgkmcnt(0)"
                 : "=&v"(lo[0]), "=&v"(lo[1]), "=&v"(lo[2]), "=&v"(lo[3]), "=&v"(hi[0]), "=&v"(hi[1]), "=&v"(hi[2]), "=&v"(hi[3])
                 : "v"(base), "n"(O0), "n"(O0 + 32), "n"(O0 + 64), "n"(O0 + 96), "n"(O1), "n"(O1 + 32), "n"(O1 + 64), "n"(O1 + 96) : "memory");
}
template <int O0, int O1>
__device__ __forceinline__ void tr_read2(unsigned base, s16x4& lo, s16x4& hi) {
    asm volatile("ds_read_b64_tr_b16 %0, %2 offset:%3\n\tds_read_b64_tr_b16 %1, %2 offset:%4\n\ts_waitcnt lgkmcnt(0)" : "=&v"(lo), "=&v"(hi) : "v"(base), "n"(O0), "n"(O1) : "memory");
}
__device__ __forceinline__ bf16x8 cat4(s16x4 lo, s16x4 hi) { return __builtin_shufflevector(lo, hi, 0, 1, 2, 3, 4, 5, 6, 7); }

__device__ __forceinline__ void phase_attn(CArgs& a, LAS unsigned char* lds, int j, int G, int c, int wv) {
    const int tid = opaque_tid(wv), lane = tid & 63, wave = __builtin_amdgcn_readfirstlane(tid >> 6), fr = lane & 15, fq = lane >> 4, q4 = (lane & 15) >> 2, p4 = lane & 3;
    const bf16_t* QKV = (const bf16_t*)(a.ws + WS_ACT + ACT_QKV); bf16_t* O = (bf16_t*)(a.ws + WS_ACT + ACT_O);
    LAS unsigned char* Kl = lds; LAS unsigned char* Vl = lds + 256 * 144;
    const unsigned vbase = (unsigned)(uintptr_t)Vl;
    constexpr float SC = 0.125f * 1.4426950408889634f;
    for (int u = c; u < 512; u += G) {
        const int b = u >> 8, n = (u >> 3) & 31, kvh = u & 7;
        __syncthreads();
        { u32x4 kb4[4], vb4[4];
#pragma unroll
          for (int i = 0; i < 4; ++i) { const int id = tid + 512 * i, row = id >> 3, ch = id & 7, pos = n * 128 - 128 + row;
              const bf16_t* src = QKV + (size_t)(b * SEQ + (pos >= 0 ? pos : 0)) * QKVN + 4096 + kvh * 64 + ch * 8; kb4[i] = *(const u32x4*)src; vb4[i] = *(const u32x4*)(src + 512); }
#pragma unroll
          for (int i = 0; i < 4; ++i) { const int id = tid + 512 * i, row = id >> 3, ch = id & 7, pos = n * 128 - 128 + row;
              const u32x4 z = zero4u(); *(LAS u32x4*)(Kl + row * 144 + ch * 16) = pos >= 0 ? kb4[i] : z; *(LAS u32x4*)(Vl + row * 144 + ch * 16) = pos >= 0 ? vb4[i] : z; } }
        __syncthreads();
        const int hq = kvh * 8 + wave; const float sink2 = a.sinks[j * 64 + hq] * 1.4426950408889634f;
        bf16x8 qn[2];
#pragma unroll
        for (int ks = 0; ks < 2; ++ks) qn[ks] = *(const bf16x8*)(QKV + (size_t)(b * SEQ + n * 128 + fr) * QKVN + hq * 64 + 32 * ks + 8 * fq);
        for (int r = 0; r < 8; ++r) {
            const int tok = b * SEQ + n * 128 + 16 * r + fr;
            bf16x8 qf[2];
#pragma unroll
            for (int ks = 0; ks < 2; ++ks) qf[ks] = qn[ks];
            if (r < 7) {
#pragma unroll
                for (int ks = 0; ks < 2; ++ks) qn[ks] = *(const bf16x8*)(QKV + (size_t)(tok + 16) * QKVN + hq * 64 + 32 * ks + 8 * fq); }
            f32x4 st[9];
#pragma unroll
            for (int kk = 0; kk < 9; ++kk) { f32x4 acc = zero4();
#pragma unroll
                for (int ks = 0; ks < 2; ++ks) { const bf16x8 kf = *(const LAS bf16x8*)(Kl + (16 * (r + kk) + fr) * 144 + (32 * ks + 8 * fq) * 2); acc = __builtin_amdgcn_mfma_f32_16x16x32_bf16(kf, qf[ks], acc, 0, 0, 0); }
                st[kk] = acc; }
            float mx = sink2;
#pragma unroll
            for (int kk = 0; kk < 9; ++kk)
#pragma unroll
                for (int ii = 0; ii < 4; ++ii) { const int jj = 4 * fq + ii; bool vis = true;
                    if (kk == 0) vis = jj > fr; if (kk == 8) vis = jj <= fr; if (n == 0 && (r + kk) < 8) vis = false;
                    const float tv = vis ? st[kk][ii] * SC : -1.0e30f; st[kk][ii] = tv; mx = fmaxf(mx, tv); }
            mx = fmaxf(mx, shx(mx, 16, lane)); mx = fmaxf(mx, shx(mx, 32, lane));
            float l = 0.f;
#pragma unroll
            for (int kk = 0; kk < 9; ++kk)
#pragma unroll
                for (int ii = 0; ii < 4; ++ii) { const float p = fast_exp2(st[kk][ii] - mx); st[kk][ii] = p; l += p; }
            l += shx(l, 16, lane); l += shx(l, 32, lane); l += fast_exp2(sink2 - mx);
            const float inv = 1.0f / l;
            f32x4 oacc[4];
            const unsigned vrow = vbase + (16 * r + 4 * fq + q4) * 144 + 8 * p4;
#pragma unroll
            for (int cc = 0; cc < 4; ++cc) oacc[cc] = zero4();
#define ATT_PV(S, K0, K1, HASK1) { u32x4 pw; pw.x = cvt_pk_bf16(st[K0][0], st[K0][1]); pw.y = cvt_pk_bf16(st[K0][2], st[K0][3]); \
                if (HASK1) { pw.z = cvt_pk_bf16(st[K1][0], st[K1][1]); pw.w = cvt_pk_bf16(st[K1][2], st[K1][3]); } else { pw.z = 0u; pw.w = 0u; } \
                const bf16x8 pf = __builtin_bit_cast(bf16x8, pw); s16x4 lo[4], hi[4]; \
                tr_read8<16 * 144 * (K0), 16 * 144 * (K1)>(vrow, lo, hi); \
                _Pragma("unroll") for (int cc = 0; cc < 4; ++cc) oacc[cc] = __builtin_amdgcn_mfma_f32_16x16x32_bf16(cat4(lo[cc], hi[cc]), pf, oacc[cc], 0, 0, 0); }
            ATT_PV(0, 0, 1, true) ATT_PV(1, 2, 3, true) ATT_PV(2, 4, 5, true) ATT_PV(3, 6, 7, true) ATT_PV(4, 8, 8, false)
#undef ATT_PV
#pragma unroll
            for (int cc = 0; cc < 4; ++cc) { const f32x4 o = oacc[cc] * inv; u32x2 w; w.x = cvt_pk_bf16(o[0], o[1]); w.y = cvt_pk_bf16(o[2], o[3]);
                *(u32x2*)(O + (size_t)tok * D + hq * 64 + 16 * cc + 4 * fq) = w; }
        }
    }
}

__device__ __forceinline__ void phase_ret(CArgs& a, LAS unsigned char* lds, int G, int c, int wv) {
    const int tid = opaque_tid(wv), lane = tid & 63, w = __builtin_amdgcn_readfirstlane(tid >> 6), fr = lane & 15, fq = lane >> 4, q4 = (lane & 15) >> 2, p4 = lane & 3;
    const bf16_t* QR = (const bf16_t*)(a.ws + WS_ACT + ACT_QR); const bf16_t* KR = (const bf16_t*)(a.ws + WS_ACT + ACT_KR); const bf16_t* VV = (const bf16_t*)(a.ws + WS_ACT + ACT_VV);
    bf16_t* OR = (bf16_t*)(a.ws + WS_ACT + ACT_OR); float* SPp = (float*)(a.ws + WS_SP);
    constexpr int KP = 528, VP = 144;
    LAS unsigned char* Kl = lds; LAS unsigned char* Vl = lds + 128 * KP; LAS unsigned char* Vzl = Vl + 128 * VP; LAS unsigned char* Rl = Vzl + 128 * VP;
    const unsigned vb0 = (unsigned)(uintptr_t)Vl + (4 * fq + q4) * VP + 8 * p4;
    const unsigned kb0 = (unsigned)(uintptr_t)Kl + (8 * fq + q4) * KP + 64 * w + 8 * p4, vzb0 = (unsigned)(uintptr_t)Vzl + (8 * fq + q4) * VP + 8 * p4;
    const unsigned koff = (unsigned)(((tid >> 5) * D + (tid & 31) * 8) * 2);
    const unsigned voff = (unsigned)(((tid >> 3) * RVW + (tid & 7) * 8) * 2);
    const unsigned qoff = (unsigned)(((16 * w + fr) * D + 8 * fq) * 2);
    for (int uidx = (G == 256) ? ((c & 7) * 32 + (c >> 3)) : c; uidx < 256; uidx += G) {
        const int b = uidx >> 7, h = (uidx >> 3) & 15, sl = uidx & 7;
        float l2g; { const double xg = 1.0 / (double)(1 << (5 + h)); double s = 0.0, p = xg; for (int k = 1; k <= 12; ++k) { s += p / k; p *= xg; } l2g = (float)(-s * 1.4426950408889634); }
        const float dchunk = fast_exp2(128.0f * l2g);
        f32x4 racc[2][4];
#pragma unroll
        for (int d = 0; d < 2; ++d)
#pragma unroll
            for (int cv = 0; cv < 4; ++cv) racc[d][cv] = zero4();
        __syncthreads();
        u32x4 kreg[8]; bf16x8 qf[8];
        { const char* kb = (const char*)(KR + (size_t)(b * SEQ) * D + h * 256); const char* qb = (const char*)(QR + (size_t)(b * SEQ) * D + h * 256);
#pragma unroll
          for (int i = 0; i < 8; ++i) kreg[i] = *(const u32x4*)(kb + (size_t)i * 16 * D * 2 + koff);
#pragma unroll
          for (int ks = 0; ks < 8; ++ks) qf[ks] = *(const bf16x8*)(qb + ks * 64 + qoff); }
        for (int nc = 0; nc < 32; ++nc) {
            const int t0 = b * SEQ + nc * 128;
#pragma unroll
            for (int d = 0; d < 2; ++d)
#pragma unroll
                for (int cv = 0; cv < 4; ++cv) { u32x2 wv; wv.x = cvt_pk_bf16(racc[d][cv][0], racc[d][cv][1]); wv.y = cvt_pk_bf16(racc[d][cv][2], racc[d][cv][3]);
                    *(LAS u32x2*)(Rl + (16 * cv + fr) * KP + (32 * w + 16 * d + 4 * fq) * 2) = wv; }
#pragma unroll
            for (int i = 0; i < 8; ++i) { const int id = tid + 512 * i, row = id >> 5, ch = id & 31; *(LAS u32x4*)(Kl + row * KP + ch * 16) = kreg[i]; }
#pragma unroll
            for (int i = 0; i < 2; ++i) { const int id = tid + 512 * i, row = id >> 3, ch = id & 7;
                const u32x4 vv = *(const u32x4*)((const char*)(VV + (size_t)t0 * RVW + h * 512 + sl * 64) + (size_t)i * 64 * RVW * 2 + voff); const float zt = fast_exp2((float)(127 - row) * l2g);
                u32x4 vz; vz.x = cvt_pk_bf16(bf_lo(vv.x) * zt, bf_hi(vv.x) * zt); vz.y = cvt_pk_bf16(bf_lo(vv.y) * zt, bf_hi(vv.y) * zt); vz.z = cvt_pk_bf16(bf_lo(vv.z) * zt, bf_hi(vv.z) * zt); vz.w = cvt_pk_bf16(bf_lo(vv.w) * zt, bf_hi(vv.w) * zt);
                *(LAS u32x4*)(Vl + row * VP + ch * 16) = vv; *(LAS u32x4*)(Vzl + row * VP + ch * 16) = vz; }
            const int tokq = t0 + 16 * w + fr;
            __syncthreads();
            if (nc + 1 < 32) { const char* kb = (const char*)(KR + (size_t)(t0 + 128) * D + h * 256);
#pragma unroll
                for (int i = 0; i < 8; ++i) kreg[i] = *(const u32x4*)(kb + (size_t)i * 16 * D * 2 + koff); }
            f32x4 oi[4];
#pragma unroll
            for (int cv = 0; cv < 4; ++cv) oi[cv] = zero4();
            if (nc > 0) {
                bf16x8 rA[4], rB[4];
#define RET_RLD(r, ks) { _Pragma("unroll") for (int cv = 0; cv < 4; ++cv) r[cv] = *(const LAS bf16x8*)(Rl + (16 * cv + fr) * KP + (32 * (ks) + 8 * fq) * 2); }
#define RET_RMM(r, ks) { _Pragma("unroll") for (int cv = 0; cv < 4; ++cv) oi[cv] = __builtin_amdgcn_mfma_f32_16x16x32_bf16(r[cv], qf[ks], oi[cv], 0, 0, 0); }
                RET_RLD(rA, 0) __builtin_amdgcn_sched_barrier(0);
                RET_RLD(rB, 1) __builtin_amdgcn_sched_barrier(0); RET_RMM(rA, 0) __builtin_amdgcn_sched_barrier(0);
                RET_RLD(rA, 2) __builtin_amdgcn_sched_barrier(0); RET_RMM(rB, 1) __builtin_amdgcn_sched_barrier(0);
                RET_RLD(rB, 3) __builtin_amdgcn_sched_barrier(0); RET_RMM(rA, 2) __builtin_amdgcn_sched_barrier(0);
                RET_RLD(rA, 4) __builtin_amdgcn_sched_barrier(0); RET_RMM(rB, 3) __builtin_amdgcn_sched_barrier(0);
                RET_RLD(rB, 5) __builtin_amdgcn_sched_barrier(0); RET_RMM(rA, 4) __builtin_amdgcn_sched_barrier(0);
                RET_RLD(rA, 6) __builtin_amdgcn_sched_barrier(0); RET_RMM(rB, 5) __builtin_amdgcn_sched_barrier(0);
                RET_RLD(rB, 7) __builtin_amdgcn_sched_barrier(0); RET_RMM(rA, 6) __builtin_amdgcn_sched_barrier(0);
                RET_RMM(rB, 7) __builtin_amdgcn_sched_barrier(0);
#undef RET_RLD
#undef RET_RMM
                const float xi = fast_exp2((float)(16 * w + fr + 1) * l2g);
#pragma unroll
                for (int cv = 0; cv < 4; ++cv) oi[cv] = oi[cv] * xi;
            }
            float dbase[4]; { float l2o = l2g; OPAQUE_V(l2o);
#pragma unroll
              for (int ii = 0; ii < 4; ++ii) dbase[ii] = fast_exp2((float)(fr - 4 * fq - ii) * l2o); }
#define RET_AB(S) if (2 * (S) <= w) { f32x4 st[2]; st[0] = zero4(); st[1] = zero4(); const bool two = 2 * (S) + 1 <= w; \
                { bf16x8 k0[4], k1[4];     \
                  _Pragma("unroll") for (int hk = 0; hk < 2; ++hk) { \
                  _Pragma("unroll") for (int ks = 0; ks < 4; ++ks) k0[ks] = *(const LAS bf16x8*)(Kl + (16 * (2 * (S)) + fr) * KP + (32 * (4 * hk + ks) + 8 * fq) * 2); \
                  _Pragma("unroll") for (int ks = 0; ks < 4; ++ks) k1[ks] = *(const LAS bf16x8*)(Kl + (16 * (two ? 2 * (S) + 1 : 2 * (S)) + fr) * KP + (32 * (4 * hk + ks) + 8 * fq) * 2); \
                  __builtin_amdgcn_sched_barrier(0); \
                  _Pragma("unroll") for (int ks = 0; ks < 4; ++ks) { st[0] = __builtin_amdgcn_mfma_f32_16x16x32_bf16(k0[ks], qf[4 * hk + ks], st[0], 0, 0, 0); st[1] = __builtin_amdgcn_mfma_f32_16x16x32_bf16(k1[ks], qf[4 * hk + ks], st[1], 0, 0, 0); } \
                  __builtin_amdgcn_sched_barrier(0); } } \
                _Pragma("unroll") for (int hb = 0; hb < 2; ++hb) { const int kb = 2 * (S) + hb; \
                    if (kb <= w) { const float bfac = fast_exp2((float)(16 * (w - kb)) * l2g); \
                        _Pragma("unroll") for (int ii = 0; ii < 4; ++ii) { const float f = dbase[ii] * bfac; st[hb][ii] = (kb < w || fr - 4 * fq - ii >= 0) ? st[hb][ii] * f : 0.f; } } \
                    else st[hb] = zero4(); } \
                u32x4 pw; pw.x = cvt_pk_bf16(st[0][0], st[0][1]); pw.y = cvt_pk_bf16(st[0][2], st[0][3]); pw.z = cvt_pk_bf16(st[1][0], st[1][1]); pw.w = cvt_pk_bf16(st[1][2], st[1][3]); \
                const bf16x8 pf = __builtin_bit_cast(bf16x8, pw); s16x4 lo[4], hi[4]; \
                tr_read8<32 * VP * (S), 32 * VP * (S) + 16 * VP>(vb0, lo, hi); \
                _Pragma("unroll") for (int cv = 0; cv < 4; ++cv) oi[cv] = __builtin_amdgcn_mfma_f32_16x16x32_bf16(cat4(lo[cv], hi[cv]), pf, oi[cv], 0, 0, 0); }
            RET_AB(0) RET_AB(1) RET_AB(2) RET_AB(3)
#undef RET_AB
            { float s1 = 0.f, s2 = 0.f;
#pragma unroll
              for (int cv = 0; cv < 4; ++cv) { s1 += (oi[cv][0] + oi[cv][1]) + (oi[cv][2] + oi[cv][3]); s2 += (oi[cv][0] * oi[cv][0] + oi[cv][1] * oi[cv][1]) + (oi[cv][2] * oi[cv][2] + oi[cv][3] * oi[cv][3]); }
              s1 += shx(s1, 16, lane); s1 += shx(s1, 32, lane); s2 += shx(s2, 16, lane); s2 += shx(s2, 32, lane);
              if (fq == 0) *(f32x2*)(SPp + ((size_t)(tokq * 16 + h) * 8 + sl) * 2) = (f32x2){s1, s2};
#pragma unroll
              for (int cv = 0; cv < 4; ++cv) { const f32x4 o = oi[cv]; u32x2 wv; wv.x = cvt_pk_bf16(o[0], o[1]); wv.y = cvt_pk_bf16(o[2], o[3]);
                  *(u32x2*)(OR + (size_t)tokq * RVW + h * 512 + sl * 64 + 16 * cv + 4 * fq) = wv; } }
            if (nc + 1 < 32) {
                { const char* qb = (const char*)(QR + (size_t)(t0 + 128) * D + h * 256);
#pragma unroll
                  for (int ks = 0; ks < 8; ++ks) qf[ks] = *(const bf16x8*)(qb + ks * 64 + qoff); } }
#pragma unroll
            for (int d = 0; d < 2; ++d)
#pragma unroll
                for (int cv = 0; cv < 4; ++cv) racc[d][cv] = racc[d][cv] * dchunk;
#define RET_C(S) { s16x4 klo[2], khi[2], vlo[4], vhi[4]; \
                tr_read2<32 * KP * (S), 32 * KP * (S) + 4 * KP>(kb0, klo[0], khi[0]); tr_read2<32 * KP * (S) + 32, 32 * KP * (S) + 4 * KP + 32>(kb0, klo[1], khi[1]); \
                tr_read8<32 * VP * (S), 32 * VP * (S) + 4 * VP>(vzb0, vlo, vhi); \
                _Pragma("unroll") for (int d = 0; d < 2; ++d) _Pragma("unroll") for (int cv = 0; cv < 4; ++cv) \
                    racc[d][cv] = __builtin_amdgcn_mfma_f32_16x16x32_bf16(cat4(klo[d], khi[d]), cat4(vlo[cv], vhi[cv]), racc[d][cv], 0, 0, 0); }
            RET_C(0) RET_C(1) RET_C(2) RET_C(3)
#undef RET_C
            __syncthreads();
        }
    }
}
__device__ __forceinline__ void phase_gn(CArgs& a, LAS unsigned char* lds, int j, int G, int c, int wv, bool dry) {
    const int tid = opaque_tid(wv), lane = tid & 63, wave = tid >> 6;
    bf16_t* OR = (bf16_t*)(a.ws + WS_ACT + ACT_OR); const bf16_t* SG = (const bf16_t*)(a.ws + WS_ACT + ACT_SG); const float* gng = a.gn_gain + (size_t)j * RVW;
    LAS float* TL = (LAS float*)lds;
    for (int i = tid; i < RVW / 4; i += 512) *(LAS f32x4*)(TL + 4 * i) = *(const f32x4*)(gng + 4 * i);
    __syncthreads();
    for (int row = c * 8 + wave; row < T; row += G * 8) {
        unsigned go = (unsigned)(uintptr_t)TL; OPAQUE_S(go); const LAS float* gl = (const LAS float*)(uintptr_t)go;
#pragma unroll 8
        for (int hh = 0; hh < 16; ++hh) { const size_t off = (size_t)row * RVW + 512 * hh + 8 * lane;
            const u32x4 ov = *(const u32x4*)(OR + off); const u32x4 gv = *(const u32x4*)(SG + off);
            float v[8] = {bf_lo(ov.x), bf_hi(ov.x), bf_lo(ov.y), bf_hi(ov.y), bf_lo(ov.z), bf_hi(ov.z), bf_lo(ov.w), bf_hi(ov.w)};
            const float g[8] = {bf_lo(gv.x), bf_hi(gv.x), bf_lo(gv.y), bf_hi(gv.y), bf_lo(gv.z), bf_hi(gv.z), bf_lo(gv.w), bf_hi(gv.w)};
            float s = 0.f;
#pragma unroll
            for (int k = 0; k < 8; ++k) s += v[k];
            const float mu = wave_sum(s, lane) * (1.0f / 512.0f); float q = 0.f;
#pragma unroll
            for (int k = 0; k < 8; ++k) { v[k] -= mu; q += v[k] * v[k]; }
            const float rstd = 1.0f / sqrtf(wave_sum(q, lane) * (1.0f / 512.0f) + GN_EPS);
            const f32x4 ga = *(const LAS f32x4*)(gl + 512 * hh + 8 * lane), gb = *(const LAS f32x4*)(gl + 512 * hh + 8 * lane + 4);
            const float gn[8] = {ga[0], ga[1], ga[2], ga[3], gb[0], gb[1], gb[2], gb[3]};
            float o[8];
#pragma unroll
            for (int k = 0; k < 8; ++k) o[k] = g[k] * (v[k] * rstd * gn[k]);
            u32x4 wv; wv.x = cvt_pk_bf16(o[0], o[1]); wv.y = cvt_pk_bf16(o[2], o[3]); wv.z = cvt_pk_bf16(o[4], o[5]); wv.w = cvt_pk_bf16(o[6], o[7]);
            *(u32x4*)((dry ? (bf16_t*)(a.ws + WS_Z) : OR) + off) = wv; }
    }
}

constexpr int NPHASE = 3 + 9 * NLAYER;
__device__ __forceinline__ CArgs& fresh_args() { CArgs* p = (CArgs*)__builtin_amdgcn_kernarg_segment_ptr(); OPAQUE_S(p); return *p; }
__global__ void __launch_bounds__(512, 2) mk_fwd(Args a_byval) {
    extern __shared__ __attribute__((aligned(16))) unsigned char lds_raw[];
    LAS unsigned char* lds = (LAS unsigned char*)lds_raw;
    const int G = gridDim.x, c = blockIdx.x;
    const int wv = __builtin_amdgcn_readfirstlane((int)threadIdx.x >> 6);
    { const int tid = opaque_tid(wv); for (int i = tid; i < (LDS_BYTES - LDSCTL_OFF) / 4; i += 512) ((LAS unsigned*)(lds + LDSCTL_OFF))[i] = 0u; }
    __syncthreads();
    { CArgs& a = fresh_args(); if (a.use_bar) { const int tid = opaque_tid(wv); if (tid == 0) (void)xb_add((unsigned*)(a.ws + WS_CTL) + CW_BAR + XB_XCNT(xb_xcc_id()), 1u); } }
    int lo, hi; { CArgs& a = fresh_args(); lo = a.ph_lo; hi = a.ph_hi; }
#ifndef SELMASK
#define SELMASK 0xffffffffu
#endif
#define SEL(b) (((SELMASK) >> (b)) & 1u)
#ifndef REP_BIT
#define REP_BIT 31
#endif
#ifndef REP_N
#define REP_N 1
#endif
#define NREP(b) (((b) == REP_BIT) ? REP_N : 1)
#define IN(k) (lo <= (k) && (k) < hi)
#define SEAM(k) do { if (IN(k) && IN((k) + 1)) { CArgs& ab = fresh_args(); XcdBarrier b2; b2.bar = (unsigned*)(ab.ws + WS_CTL) + CW_BAR; b2.x = xb_xcc_id(); b2.st = (volatile LAS unsigned*)(lds + LDSCTL_OFF + 512); xcd_barrier(b2, opaque_tid(wv)); } } while (0)
    for (int rp_ = 0; rp_ < NREP(0); ++rp_) { if (SEL(0) && IN(0)) { phase_prep(fresh_args(), lds, G, c, wv); } SEAM(0); }
    if (SEL(1) && IN(1)) { phase_modreduce(fresh_args(), G, c, wv); } SEAM(1);
    for (int rp_ = 0; rp_ < NREP(2); ++rp_) { if (SEL(2) && IN(2)) { phase_u0(fresh_args(), lds, G, c, wv); } SEAM(2); }
    for (int layer = 0; layer < NLAYER; ++layer) {
        const int pb = 3 + 9 * layer, j = layer >> 1;
        if ((layer & 1) == 0) {
            for (int rp_ = 0; rp_ < NREP(3); ++rp_) { if (SEL(3) && IN(pb + 0)) { CArgs& a = fresh_args(); unsigned char* ws = a.ws; pg8::StaticOrder S; S.init((const bf16_t*)(ws + WS_U), (const bf16_t*)(ws + WS_W + W_QKV) + (size_t)j * QKVN * D, T, QKVN, D, G, c);
                pg8::EpiQKV E{(bf16_t*)(ws + WS_ACT + ACT_QKV), (const float*)(ws + WS_BQKV) + j * QKVN, (const float*)(ws + WS_CSA), (const float*)(ws + WS_CSA) + T * 8};
                pg8::gemm_phase<pg8::EpiQKV, pg8::StaticOrder, false>(lds, D, S, E, wv);
                { const int idle0 = S.nwg % G;
                  if (idle0 > 0 && c >= idle0) { const int tid = opaque_tid(wv); prep_items(fresh_args(), lds, __builtin_amdgcn_readfirstlane(tid >> 6), tid & 63, (c - idle0) * 8 + __builtin_amdgcn_readfirstlane(tid >> 6), (G - idle0) * 8, 1 + (layer >> 1)); __syncthreads(); } } } SEAM(pb + 0); }
            for (int rp_ = 0; rp_ < NREP(4); ++rp_) { if (SEL(4) && IN(pb + 1)) { phase_attn(fresh_args(), lds, j, G, c, wv); } SEAM(pb + 1); }
        } else {
            for (int rp_ = 0; rp_ < NREP(5); ++rp_) { if (SEL(5) && IN(pb + 0)) { CArgs& a = fresh_args(); unsigned char* ws = a.ws; pg8::StaticOrder S; S.init((const bf16_t*)(ws + WS_U), (const bf16_t*)(ws + WS_W + W_RET) + (size_t)j * RETN * D, T, RET_QKV, D, G, c);
                pg8::EpiRet E{(bf16_t*)(ws + WS_ACT + ACT_QR), (bf16_t*)(ws + WS_ACT + ACT_KR), (bf16_t*)(ws + WS_ACT + ACT_VV), (const float*)(ws + WS_CSR)};
                pg8::gemm_phase<pg8::EpiRet, pg8::StaticOrder, false>(lds, D, S, E, wv); } SEAM(pb + 0); }
            for (int rp_ = 0; rp_ < NREP(6); ++rp_) { if (SEL(6) && IN(pb + 1)) { phase_ret(fresh_args(), lds, G, c, wv); } SEAM(pb + 1); }
            for (int rp_ = NREP(7) - 1; rp_ >= 0; --rp_) { if (SEL(7) && IN(pb + 2)) { CArgs& a = fresh_args(); unsigned char* ws = a.ws; pg8::StaticOrder S; S.init((const bf16_t*)(ws + WS_U), (const bf16_t*)(ws + WS_W + W_RET) + ((size_t)j * RETN + RET_QKV) * D, T, RVW, D, G, c);
                pg8::EpiG E{(bf16_t*)(ws + WS_ACT + ACT_OR), (const float*)(ws + WS_SP), a.gn_gain + (size_t)j * RVW, (LAS float*)(lds + LDS_GNST), (bf16_t*)(ws + WS_ACT + (rp_ > 0 ? ACT_SG : ACT_OR))};
                pg8::gemm_phase<pg8::EpiG, pg8::StaticOrder, false>(lds, D, S, E, wv); } SEAM(pb + 2); }
        }
        for (int rp_ = 0; rp_ < NREP(8); ++rp_) { if (SEL(8) && IN(pb + 3)) { CArgs& a = fresh_args(); unsigned char* ws = a.ws; const bool at = (layer & 1) == 0; const int K = at ? D : RVW;
            pg8::StaticOrder S; S.init(at ? (const bf16_t*)(ws + WS_ACT + ACT_O) : (const bf16_t*)(ws + WS_ACT + ACT_OR), at ? (const bf16_t*)(ws + WS_W + W_OA) + (size_t)j * D * D : (const bf16_t*)(ws + WS_W + W_OR) + (size_t)j * D * RVW, T, D, K, G, c);
            pg8::EpiZ E{(bf16_t*)(ws + WS_Z), at ? a.b_oa + (size_t)j * D : nullptr, (const float*)(ws + WS_MODL) + (size_t)layer * 2 * 24576 + 2 * D};
            pg8::gemm_phase<pg8::EpiZ, pg8::StaticOrder, false>(lds, K, S, E, wv); } SEAM(pb + 3); }
        for (int rp_ = NREP(9) - 1; rp_ >= 0; --rp_) { if (SEL(9) && IN(pb + 4)) { phase_ln1(fresh_args(), lds, layer, G, c, wv, rp_ > 0); } SEAM(pb + 4); }
        for (int rp_ = 0; rp_ < NREP(10); ++rp_)
        for (int st = 0; st < 3; ++st) { const int ph = pb + 5 + st;
            if (IN(ph)) { CArgs& a = fresh_args(); unsigned char* ws = a.ws; const int ntile = moe_tables(a, lds, layer, wv, st > 0 && lo < ph);
                const int cx = (G == 256) ? ((c & 7) * 32 + (c >> 3)) : c;
                const int Ub = 2 * ntile, R1 = (Ub >= G ? (Ub / G) * G : Ub) & ~1, nlate = Ub - R1, Dm = (R1 >> 1) * 16;
                if (SEL(10) && (st == 0 || (st == 1 && cx < nlate))) {
                    pg8::GuOrder S{G, cx, st == 0 ? 0 : R1, st == 0 ? R1 : Ub, (const LAS int*)(lds + LDSCTL_OFF), (const LAS int*)(lds + LDSCTL_OFF) + 64, (const int*)(ws + WS_ROWS), (const bf16_t*)(ws + WS_U), (const bf16_t*)(ws + WS_W + W_GU) + (size_t)layer * NEXP * GUW * D};
                    pg8::EpiGU E{(bf16_t*)(ws + WS_ACT + ACT_H), a.b_gu + (size_t)layer * NEXP * GUW};
                    pg8::gemm_phase<pg8::EpiGU, pg8::GuOrder, true>(lds, D, S, E, wv); }
                if (SEL(11) && st >= 1) {
                    pg8::DownOrder S{G, cx, st == 1 ? 0 : Dm, st == 1 ? Dm : ntile * 16, st == 1 ? nlate : 0, (const LAS int*)(lds + LDSCTL_OFF), (const LAS int*)(lds + LDSCTL_OFF) + 64, (const bf16_t*)(ws + WS_ACT + ACT_H), (const bf16_t*)(ws + WS_W + W_DN) + (size_t)layer * NEXP * D * EFF};
                    pg8::EpiDown E{(unsigned char*)(ws + WS_ACT + ACT_YP), a.b_dn + (size_t)layer * NEXP * D};
                    pg8::gemm_phase<pg8::EpiDown, pg8::DownOrder, false>(lds, a.k_dn, S, E, wv); } }
            SEAM(ph); }
        for (int rp_ = NREP(12) - 1; rp_ >= 0; --rp_) { if (SEL(12) && IN(pb + 8)) { phase_ln2(fresh_args(), lds, layer, G, c, wv, rp_ > 0, lo < pb + 8); } SEAM(pb + 8); }
    }
#undef IN
#undef SEAM
}

extern "C" void kernel_launch(void* const* d_in, const int* in_sizes, int n_in, void* d_out, int out_size, void* d_ws, size_t ws_size, hipStream_t stream) {
    static int grid = 0;
    if (grid == 0) {
        if (n_in != 22 || ws_size < WS_END) { fprintf(stderr, "kernel_launch: unexpected n_in %d or ws_size %zu (< %zu)\n", n_in, ws_size, (size_t)WS_END); grid = -1; return; }
        int dev = 0, cus = 0, per_cu = 0;
        if (hipGetDevice(&dev) != hipSuccess || hipDeviceGetAttribute(&cus, hipDeviceAttributeMultiprocessorCount, dev) != hipSuccess) { grid = -1; return; }
        if (hipFuncSetAttribute((const void*)mk_fwd, hipFuncAttributeMaxDynamicSharedMemorySize, LDS_BYTES) != hipSuccess) { fprintf(stderr, "kernel_launch: hipFuncSetAttribute failed\n"); grid = -1; return; }
        if (hipOccupancyMaxActiveBlocksPerMultiprocessor(&per_cu, (const void*)mk_fwd, 512, LDS_BYTES) != hipSuccess || per_cu < 1) fprintf(stderr, "kernel_launch: occupancy query reports %d\n", per_cu);
        (void)hipGetLastError();
        grid = cus;
    }
    if (grid < 0) return;
    (void)hipMemsetAsync((char*)d_ws + WS_CTL, 0, CTL_BYTES, stream);
    Args a{};
    a.x = (const float*)d_in[0]; a.c = (const float*)d_in[1]; a.pos = (const int*)d_in[2]; a.mod_w = (const float*)d_in[3]; a.mod_b = (const float*)d_in[4]; a.mod_layer = (const float*)d_in[5];
    a.ln_gain = (const float*)d_in[6]; a.ln_bias = (const float*)d_in[7]; a.w_qkv = (const float*)d_in[8]; a.b_qkv = (const float*)d_in[9]; a.sinks = (const float*)d_in[10];
    a.w_oa = (const float*)d_in[11]; a.b_oa = (const float*)d_in[12]; a.w_ret = (const float*)d_in[13]; a.gn_gain = (const float*)d_in[14]; a.w_or = (const float*)d_in[15];
    a.router_w = (const float*)d_in[16]; a.router_b = (const float*)d_in[17]; a.w_gu = (const float*)d_in[18]; a.b_gu = (const float*)d_in[19]; a.w_dn = (const float*)d_in[20]; a.b_dn = (const float*)d_in[21];
    a.out = (float*)d_out; a.ws = (unsigned char*)d_ws; a.k_dn = EFF;
#if MK_ONE_LAUNCH
    a.ph_lo = 0; a.ph_hi = NPHASE; a.use_bar = 1;
    hipLaunchKernelGGL(mk_fwd, dim3(grid), dim3(512), LDS_BYTES, stream, a);
#else
    a.use_bar = 0;
    for (int p = 0; p < NPHASE; ++p) { if (p >= 3 && (((p - 3) / 9) & 1) == 0 && ((p - 3) % 9) == 2) continue;
        a.ph_lo = p; a.ph_hi = p + 1; hipLaunchKernelGGL(mk_fwd, dim3(grid), dim3(512), LDS_BYTES, stream, a); }
#endif
}
```

```cpp
#include <hip/hip_runtime.h>
#include <cstdio>
#include <cstdint>

#ifndef MK_ONE_LAUNCH
#define MK_ONE_LAUNCH 1
#endif

#define LAS __attribute__((address_space(3)))
typedef unsigned short bf16_t;
typedef short bf16x8 __attribute__((ext_vector_type(8)));
typedef short s16x4 __attribute__((ext_vector_type(4)));
typedef float f32x4 __attribute__((ext_vector_type(4)));
typedef float f32x2 __attribute__((ext_vector_type(2)));
typedef unsigned u32x4 __attribute__((ext_vector_type(4)));
typedef unsigned u32x2 __attribute__((ext_vector_type(2)));

constexpr int NB = 2, SEQ = 4096, T = NB * SEQ, D = 4096, NLAYER = 4;
constexpr int QKVN = 5120, RETN = 24576, RVW = 8192, RET_QKV = 16384;
constexpr int NEXP = 32, EFF = 256, GUW = 512, ECAP = 8192, MAXSLOT = 40960;
constexpr float ALPHA = 1.6817928305074290f;
constexpr float LN_EPS = 1e-5f, GN_EPS = 1e-6f;
constexpr float YP_SCALE = 8.0f;

constexpr size_t MiB = (size_t)1 << 20;
constexpr size_t WS_CTL = 0, CTL_BYTES = 1 * MiB;
constexpr size_t WS_MODP = 1 * MiB;
constexpr size_t WS_MODL = 8 * MiB;
constexpr size_t WS_CSA = 9 * MiB;
constexpr size_t WS_CSR = 10 * MiB;
constexpr size_t WS_BQKV = 18 * MiB;
constexpr size_t WS_TK = 19 * MiB;
constexpr size_t WS_ROWS = 20 * MiB;
constexpr size_t WS_U = 32 * MiB;
constexpr size_t WS_Z = 96 * MiB;
constexpr size_t WS_SP = WS_Z + 64 * MiB;
constexpr size_t WS_ACT = 224 * MiB;
constexpr size_t ACT_QKV = 0, ACT_O = 80 * MiB;
constexpr size_t ACT_QR = 0, ACT_KR = 64 * MiB, ACT_VV = 128 * MiB, ACT_SG = 256 * MiB, ACT_OR = 384 * MiB;
constexpr size_t ACT_H = 0, ACT_YP = 32 * MiB;
constexpr size_t WS_W = 736 * MiB;
constexpr size_t W_QKV = 0, W_OA = 80 * MiB, W_RET = 144 * MiB, W_OR = 528 * MiB, W_GU = 656 * MiB, W_DN = 1168 * MiB, W_END = 1424 * MiB;
constexpr size_t WS_XB = WS_W + W_END;
constexpr size_t WS_T16 = WS_XB + 64 * MiB;
constexpr size_t WS_END = WS_T16 + 1 * MiB;
constexpr int CW_BAR = 1024, CW_CNT = 8192;

constexpr int LDS_STAGE = 131072;
constexpr int LDSCTL_OFF = 149504;
constexpr int LDS_BYTES = 156672;
constexpr int LDS_GNST = LDSCTL_OFF + 3072;

typedef __bf16 bf16x2_t __attribute__((ext_vector_type(2)));
__device__ __forceinline__ unsigned cvt_pk_bf16(float lo, float hi) { const f32x2 v = {lo, hi}; return __builtin_bit_cast(unsigned, __builtin_convertvector(v, bf16x2_t)); }
typedef _Float16 h16x2_t __attribute__((ext_vector_type(2)));
__device__ __forceinline__ unsigned cvt_pk_f16(float lo, float hi) { const f32x2 v = {lo, hi}; return __builtin_bit_cast(unsigned, __builtin_convertvector(v, h16x2_t)); }
__device__ __forceinline__ float h_lo(unsigned w) { return (float)__builtin_bit_cast(h16x2_t, w)[0]; }
__device__ __forceinline__ float h_hi(unsigned w) { return (float)__builtin_bit_cast(h16x2_t, w)[1]; }
__device__ __forceinline__ float bf_lo(unsigned w) { return __uint_as_float(w << 16); }
__device__ __forceinline__ float bf_hi(unsigned w) { return __uint_as_float(w & 0xffff0000u); }
__device__ __forceinline__ float shx(float v, int mask, int lane) { return __int_as_float(__builtin_amdgcn_ds_bpermute((lane ^ mask) << 2, __float_as_int(v))); }
__device__ __forceinline__ float wave_sum(float v, int lane) {
#pragma unroll
    for (int o = 1; o < 64; o <<= 1) v += shx(v, o, lane);
    return v;
}
__device__ __forceinline__ u32x4 zero4u() { unsigned z = 0u; asm volatile("" : "+v"(z)); return (u32x4){z, z, z, z}; }
__device__ __forceinline__ f32x4 zero4() { float z = 0.f; asm volatile("" : "+v"(z)); return (f32x4){z, z, z, z}; }
__device__ __forceinline__ float fast_exp2(float x) { return __builtin_amdgcn_exp2f(x); }
__device__ __forceinline__ float fast_rcp(float x) { return __builtin_amdgcn_rcpf(x); }

#define OPAQUE_V(x) asm volatile("" : "+v"(x))
#define OPAQUE_S(x) asm volatile("" : "+s"(x))
__device__ __forceinline__ int opaque_tid(int wv) { unsigned m = ~0u; OPAQUE_S(m); int t = (wv << 6) | (int)__builtin_amdgcn_mbcnt_hi(m, __builtin_amdgcn_mbcnt_lo(m, 0u)); OPAQUE_V(t); return t; }
namespace pg8 {
constexpr int BM = 256, BK = 64, HALF = 128, HTB = HALF * BK * 2, STAGE_BYTES = 8 * HTB, NXCD = 8, WGM = 8;
__host__ __device__ __forceinline__ int lds_byte(int r, int c) { const int st = (r >> 4) * 2 + (c >> 5), rr = r & 15, cc = c & 31, ob = rr * 64 + cc * 2; return st * 1024 + (ob ^ (((ob >> 9) & 1) << 5)); }
__host__ __device__ __forceinline__ void stage_rc(int b, int& R, int& C) { const int st = b / 1024, sb = b % 1024, swz = sb ^ (((sb >> 9) & 1) << 5); R = (st >> 1) * 16 + swz / 64; C = (st & 1) * 32 + (swz % 64) / 2; }
__host__ __device__ __forceinline__ int perm32(int rho) { const int n = rho >> 4, i = rho & 15; return 8 * (i >> 2) + 4 * n + (i & 3); }

struct Unit { int pm, pn, e, rt, valid, seq; };

struct StaticOrder {
    static constexpr bool SKIP = false;
    int nM, nN, nwg, G, c; const bf16_t* A; const bf16_t* Bt; int K;
    __device__ void init(const bf16_t* A_, const bf16_t* Bt_, int M, int N, int K_, int G_, int c_) { A = A_; Bt = Bt_; K = K_; nM = M / BM; nN = N / BM; nwg = nM * nN; G = G_; c = c_; }
    __device__ __forceinline__ bool next(int i, Unit& u) const {
        const long L = (long)i * G + c; if (L >= nwg) return false;
        int wgid = (int)L; { const int q = nwg / NXCD, r = nwg % NXCD, xcd = wgid % NXCD, off = wgid / NXCD; wgid = (xcd < r ? xcd * (q + 1) : r * (q + 1) + (xcd - r) * q) + off; }
        const int nig = WGM * nN, gid = wgid / nig, fm = gid * WGM, gsz = (nM - fm) < WGM ? (nM - fm) : WGM;
        u = Unit{fm + ((wgid % nig) % gsz), (wgid % nig) / gsz, 0, 0, BM, i}; return true;
    }
    __device__ __forceinline__ const char* a_base(const Unit& u) const { return (const char*)A + (size_t)u.pm * BM * K * 2; }
    __device__ __forceinline__ const char* b_base(const Unit& u) const { return (const char*)Bt + (size_t)u.pn * BM * K * 2; }
    __device__ __forceinline__ int row_token(const Unit&, int r) const { return r; }
};

template <class Epi, class Sched, bool GATHER>
__device__ __forceinline__ void gemm_phase(LAS unsigned char* lds, const int K, const Sched& S, const Epi& E, const int wv) {
    const int tid = opaque_tid(wv), wid = __builtin_amdgcn_readfirstlane(tid >> 6), lane = tid & 63, wr = wid >> 2, wc = wid & 3, fr = lane & 15, fq = lane >> 4;
    const int nt = K / BK;
    unsigned voffB[2], cvA[2][2], nvA[2][2]; int Rr[2], Cc[2];
#pragma unroll
    for (int i = 0; i < 2; ++i) { int R, C; stage_rc(tid * 16 + i * 8192, R, C); Rr[i] = R; Cc[i] = C; const int Rb = Epi::WIDE ? (64 * (R >> 5) + 16 * ((R >> 2) & 3) + 4 * ((R >> 4) & 1) + (R & 3)) : Epi::PERM ? ((R & ~31) + perm32(R & 31)) : R;
        voffB[i] = (unsigned)(Rb * K + C) * 2u; }
    const size_t kstep = (size_t)(BK * 2);
    const size_t hstep = Epi::WIDE ? (size_t)8 * K * 2 : (size_t)HALF * K * 2;
    const unsigned ldsw = (unsigned)wid * 1024u;
    const int aoff = lds_byte(wr * 64 + fr, fq * 8), boff = lds_byte(wc * 32 + fr, fq * 8);
#define PG8_SA(b, h) (((b) * 2 + (h)) * HTB)
#define PG8_SB(b, h) ((4 + (b) * 2 + (h)) * HTB)
#define PG8_STAGE_B(bufoff, gbase) do { _Pragma("unroll") for (int _i = 0; _i < 2; ++_i) \
        __builtin_amdgcn_global_load_lds((const unsigned*)((const char*)(gbase) + voffB[_i]), (LAS unsigned*)(lds + (bufoff) + ldsw + _i * 8192), 16, 0, 0); } while (0)
#define PG8_STAGE_A(bufoff, gbase, v0, v1) do { \
        __builtin_amdgcn_global_load_lds((const unsigned*)((const char*)(gbase) + (v0)), (LAS unsigned*)(lds + (bufoff) + ldsw), 16, 0, 0); \
        __builtin_amdgcn_global_load_lds((const unsigned*)((const char*)(gbase) + (v1)), (LAS unsigned*)(lds + (bufoff) + ldsw + 8192), 16, 0, 0); } while (0)
#define PG8_LDA(dst, b, h) do { _Pragma("unroll") for (int m = 0; m < 4; ++m) _Pragma("unroll") for (int k = 0; k < 2; ++k) dst[m][k] = *(const LAS bf16x8*)(lds + PG8_SA(b, h) + aoff + m * 2048 + k * 1024); } while (0)
#define PG8_LDB(dst, b, h) do { _Pragma("unroll") for (int n = 0; n < 2; ++n) _Pragma("unroll") for (int k = 0; k < 2; ++k) dst[n][k] = *(const LAS bf16x8*)(lds + PG8_SB(b, h) + boff + n * 2048 + k * 1024); } while (0)
#define PG8_MMA(ai, bj, At, Bt) do { __builtin_amdgcn_s_setprio(1); if (Sched::SKIP) OPAQUE_S(mmask); _Pragma("unroll") for (int m = 0; m < 4; ++m) { if (!Sched::SKIP || __builtin_expect((mmask >> (4 * (ai) + m)) & 1, 1)) { _Pragma("unroll") for (int n = 0; n < 2; ++n) _Pragma("unroll") for (int k = 0; k < 2; ++k) \
        acc[ai][bj][m][n] = __builtin_amdgcn_mfma_f32_16x16x32_bf16(Bt[n][k], At[m][k], acc[ai][bj][m][n], 0, 0, 0); } } __builtin_amdgcn_s_setprio(0); } while (0)
#define PG8_WAIT_V(n) asm volatile("s_waitcnt vmcnt(" #n ")" ::: "memory")
#define PG8_WAIT_L(n) asm volatile("s_waitcnt lgkmcnt(" #n ")" ::: "memory")
#define PG8_BAR __builtin_amdgcn_s_barrier()
#define PG8_SCHED __builtin_amdgcn_sched_barrier(0)
    Unit cur, nxt; int ui = 0;
    if (!S.next(0, cur)) return;
    f32x4 acc[2][2][4][2];
    if constexpr (Epi::ACC_BIAS) { f32x4 bv0[2][2]; E.bias_load(cur, wc, fq, bv0);
#pragma unroll
        for (int a = 0; a < 2; ++a)
#pragma unroll
            for (int b = 0; b < 2; ++b)
#pragma unroll
                for (int m = 0; m < 4; ++m)
#pragma unroll
                    for (int n = 0; n < 2; ++n) acc[a][b][m][n] = bv0[b][n];
    } else {
#pragma unroll
    for (int a = 0; a < 2; ++a)
#pragma unroll
        for (int b = 0; b < 2; ++b)
#pragma unroll
            for (int m = 0; m < 4; ++m)
#pragma unroll
                for (int n = 0; n < 2; ++n) acc[a][b][m][n] = zero4();
    }
    bf16x8 At[4][2], B0[2][2], B1[2][2];
    int mmask = 255;
#define PG8_MCV(u) do { mmask = 0; _Pragma("unroll") for (int h_ = 0; h_ < 2; ++h_) { int q_ = ((u).valid - 128 * h_ - 64 * wr + 15) >> 4; q_ = q_ < 0 ? 0 : q_; q_ = q_ > 4 ? 4 : q_; mmask |= ((1 << q_) - 1) << (4 * h_); } mmask = __builtin_amdgcn_readfirstlane(mmask); } while (0)
    PG8_MCV(cur);
    const char* cA = S.a_base(cur); const char* cB = S.b_base(cur);
#pragma unroll
    for (int h = 0; h < 2; ++h)
#pragma unroll
        for (int i = 0; i < 2; ++i) { const int tok = GATHER ? S.row_token(cur, h * HALF + Rr[i]) : (h * HALF + Rr[i]); cvA[h][i] = (unsigned)(tok * K + Cc[i]) * 2u; nvA[h][i] = cvA[h][i]; }
    PG8_STAGE_B(PG8_SB(0, 0), cB); PG8_STAGE_B(PG8_SB(0, 1), cB + hstep); PG8_STAGE_A(PG8_SA(0, 0), cA, cvA[0][0], cvA[0][1]); PG8_STAGE_A(PG8_SA(0, 1), cA, cvA[1][0], cvA[1][1]);
    if (wr == 1) PG8_BAR;
    PG8_WAIT_V(2); PG8_BAR;
    PG8_STAGE_B(PG8_SB(1, 0), cB + kstep); PG8_STAGE_A(PG8_SA(1, 0), cA + kstep, cvA[0][0], cvA[0][1]); PG8_STAGE_B(PG8_SB(1, 1), cB + hstep + kstep);
    PG8_WAIT_V(6); PG8_BAR;
    for (;;) {
        const bool has_next = S.next(ui + 1, nxt);
        const char* nA = has_next ? S.a_base(nxt) : cA; const char* nB = has_next ? S.b_base(nxt) : cB;
        if (GATHER) {
#pragma unroll
            for (int h = 0; h < 2; ++h)
#pragma unroll
                for (int i = 0; i < 2; ++i) { if (has_next) { const int tok = S.row_token(nxt, h * HALF + Rr[i]); nvA[h][i] = (unsigned)(tok * K + Cc[i]) * 2u; } else nvA[h][i] = cvA[h][i]; }
        }
        for (int t = 0; t < nt; t += 2) {
            const bool last = (t == nt - 2);
            const char* a1 = cA + (size_t)(t + 1) * kstep;
            const char* a2 = last ? nA : cA + (size_t)(t + 2) * kstep; const char* b2 = last ? nB : cB + (size_t)(t + 2) * kstep;
            const char* a3 = a2 + kstep; const char* b3 = b2 + kstep;
            const unsigned w00 = (GATHER && last) ? nvA[0][0] : cvA[0][0], w01 = (GATHER && last) ? nvA[0][1] : cvA[0][1];
            const unsigned w10 = (GATHER && last) ? nvA[1][0] : cvA[1][0], w11 = (GATHER && last) ? nvA[1][1] : cvA[1][1];
            PG8_LDB(B0, 0, 0); PG8_LDB(B1, 0, 1); PG8_SCHED; PG8_LDA(At, 0, 0); PG8_STAGE_A(PG8_SA(1, 1), a1, cvA[1][0], cvA[1][1]);
            PG8_WAIT_V(8); PG8_WAIT_L(0); PG8_BAR; PG8_MMA(0, 0, At, B0); PG8_MMA(0, 1, At, B1); PG8_BAR; PG8_SCHED;
            PG8_LDA(At, 0, 1); PG8_STAGE_B(PG8_SB(0, 0), b2); PG8_STAGE_B(PG8_SB(0, 1), b2 + hstep); PG8_STAGE_A(PG8_SA(0, 0), a2, w00, w01);
            PG8_WAIT_V(8); PG8_WAIT_L(0); PG8_BAR; PG8_MMA(1, 0, At, B0); PG8_MMA(1, 1, At, B1); PG8_BAR; PG8_SCHED;
            PG8_LDB(B0, 1, 0); PG8_LDB(B1, 1, 1); PG8_SCHED; PG8_LDA(At, 1, 0); PG8_STAGE_A(PG8_SA(0, 1), a2, w10, w11);
            PG8_WAIT_V(8); PG8_WAIT_L(0); PG8_BAR; PG8_MMA(0, 0, At, B0); PG8_MMA(0, 1, At, B1); PG8_BAR; PG8_SCHED;
            PG8_LDA(At, 1, 1); PG8_STAGE_B(PG8_SB(1, 0), b3); PG8_STAGE_B(PG8_SB(1, 1), b3 + hstep); PG8_STAGE_A(PG8_SA(1, 0), a3, w00, w01);
            PG8_WAIT_V(8); PG8_WAIT_L(0); PG8_BAR; PG8_MMA(1, 0, At, B0); PG8_MMA(1, 1, At, B1); PG8_BAR; PG8_SCHED;
        }
        if (wr == 0) PG8_BAR;
        f32x4 nbv[2][2];
        if constexpr (Epi::ACC_BIAS) { E.bias_load_untracked(has_next ? nxt : cur, wc, fq, nbv); PG8_SCHED; }
        E(acc, cur, wr, wc, fr, fq);
        if constexpr (Epi::ACC_BIAS) { static_assert(Epi::NSTORE == 8, "counted wait below"); asm volatile("s_waitcnt vmcnt(6)" : "+v"(nbv[0][0]), "+v"(nbv[0][1]), "+v"(nbv[1][0]), "+v"(nbv[1][1]) :: "memory"); }
        if (!has_next) break;
#pragma unroll
        for (int a = 0; a < 2; ++a)
#pragma unroll
            for (int b = 0; b < 2; ++b)
#pragma unroll
                for (int m = 0; m < 4; ++m)
#pragma unroll
                    for (int n = 0; n < 2; ++n) { if constexpr (Epi::ACC_BIAS) acc[a][b][m][n] = nbv[b][n]; else acc[a][b][m][n] = zero4(); }
        cur = nxt; cA = nA; cB = nB; ++ui; PG8_MCV(cur);
#pragma unroll
        for (int h = 0; h < 2; ++h)
#pragma unroll
            for (int i = 0; i < 2; ++i) cvA[h][i] = nvA[h][i];
        if (wr == 1) PG8_BAR;
    }
    PG8_WAIT_V(0);
    PG8_BAR;
#undef PG8_MCV
#undef PG8_SA
#undef PG8_SB
#undef PG8_STAGE_A
#undef PG8_STAGE_B
#undef PG8_LDA
#undef PG8_LDB
#undef PG8_MMA
#undef PG8_WAIT_V
#undef PG8_WAIT_L
#undef PG8_BAR
#undef PG8_SCHED
}

struct EpiQKV {
    static constexpr bool PERM = true; static constexpr bool WIDE = false; static constexpr bool ACC_BIAS = false;
    bf16_t* O; const float* bias; const float* cosA; const float* sinA;
    __device__ __forceinline__ void operator()(const f32x4 (&acc)[2][2][4][2], const Unit& u, int wr, int wc, int fr, int fq) const {
        const int row0 = u.pm * BM + wr * 64 + fr, col0 = u.pn * BM + wc * 32 + 8 * fq;
        const bool rope = (u.pn < 18) && ((wc & 1) == 0) && (fq < 2);
        f32x4 bv[2][2];
#pragma unroll
        for (int bj = 0; bj < 2; ++bj)
#pragma unroll
            for (int n = 0; n < 2; ++n) bv[bj][n] = *(const f32x4*)(bias + col0 + bj * HALF + 4 * n);
#pragma unroll
        for (int ai = 0; ai < 2; ++ai)
#pragma unroll
            for (int m = 0; m < 4; ++m) { const int row = row0 + ai * HALF + m * 16;
                f32x4 cs = *(const f32x4*)(cosA + (size_t)row * 8 + 4 * (fq & 1)), sn = *(const f32x4*)(sinA + (size_t)row * 8 + 4 * (fq & 1));

#pragma unroll
                for (int jx = 0; jx < 4; ++jx) { cs[jx] = rope ? cs[jx] : 1.0f; sn[jx] = rope ? sn[jx] : 0.0f; }
                bf16_t* rowp = O + (size_t)row * QKVN + col0;
#pragma unroll
                for (int bj = 0; bj < 2; ++bj) { const f32x4 v0 = acc[ai][bj][m][0] + bv[bj][0], v1 = acc[ai][bj][m][1] + bv[bj][1];
                    const f32x4 o0 = v0 * cs - v1 * sn, o1 = v1 * cs + v0 * sn;
                    u32x4 w; w.x = cvt_pk_bf16(o0[0], o0[1]); w.y = cvt_pk_bf16(o0[2], o0[3]); w.z = cvt_pk_bf16(o1[0], o1[1]); w.w = cvt_pk_bf16(o1[2], o1[3]);
                    *(u32x4*)(rowp + bj * HALF) = w; } }
    }
};
struct EpiRet {
    static constexpr bool PERM = true; static constexpr bool WIDE = false; static constexpr bool ACC_BIAS = false;
    bf16_t *QR, *KR, *VV; const float* csR;
    __device__ __forceinline__ void operator()(const f32x4 (&acc)[2][2][4][2], const Unit& u, int wr, int wc, int fr, int fq) const {
        const int row0 = u.pm * BM + wr * 64 + fr, colt = wc * 32 + 8 * fq, pn = u.pn;
        if (pn < 32) {
            bf16_t* dst = pn < 16 ? QR : KR; const int hc = (pn & 15) * 256; const float sc = pn < 16 ? 1.f : 0.0625f;
#pragma unroll
            for (int ai = 0; ai < 2; ++ai)
#pragma unroll
                for (int m = 0; m < 4; ++m) { const int row = row0 + ai * HALF + m * 16;
#pragma unroll
                    for (int bj = 0; bj < 2; ++bj) { f32x4 o[2];
#pragma unroll
                        for (int n = 0; n < 2; ++n) { const int i0 = 64 * bj + 16 * wc + 4 * fq + 2 * n;
                            const f32x4 t = *(const f32x4*)(csR + ((size_t)row * 128 + i0) * 2); const f32x4 v = acc[ai][bj][m][n];
                            o[n] = (f32x4){(v[0] * t[0] - v[1] * t[1]) * sc, (v[1] * t[0] + v[0] * t[1]) * sc, (v[2] * t[2] - v[3] * t[3]) * sc, (v[3] * t[2] + v[2] * t[3]) * sc}; }
                        u32x4 w; w.x = cvt_pk_bf16(o[0][0], o[0][1]); w.y = cvt_pk_bf16(o[0][2], o[0][3]); w.z = cvt_pk_bf16(o[1][0], o[1][1]); w.w = cvt_pk_bf16(o[1][2], o[1][3]);
                        *(u32x4*)(dst + (size_t)row * D + hc + bj * HALF + colt) = w; } }
        } else {
            bf16_t* dst = VV; const int hc = (pn - 32) * 256;
#pragma unroll
            for (int ai = 0; ai < 2; ++ai)
#pragma unroll
                for (int m = 0; m < 4; ++m) { const int row = row0 + ai * HALF + m * 16;
#pragma unroll
                    for (int bj = 0; bj < 2; ++bj) { f32x4 o[2];
#pragma unroll
                        for (int n = 0; n < 2; ++n) o[n] = acc[ai][bj][m][n];
                        u32x4 w; w.x = cvt_pk_bf16(o[0][0], o[0][1]); w.y = cvt_pk_bf16(o[0][2], o[0][3]); w.z = cvt_pk_bf16(o[1][0], o[1][1]); w.w = cvt_pk_bf16(o[1][2], o[1][3]);
                        *(u32x4*)(dst + (size_t)row * RVW + hc + bj * HALF + colt) = w; } }
        }
    }
};
struct EpiG {
    static constexpr bool PERM = true; static constexpr bool WIDE = false; static constexpr bool ACC_BIAS = false;
    bf16_t* OR; const float* SP; const float* gng; LAS float* st; bf16_t* OW;
    __device__ __forceinline__ void operator()(const f32x4 (&acc)[2][2][4][2], const Unit& u, int wr, int wc, int fr, int fq) const {
        const int tid = (wr * 4 + wc) * 64 + fq * 16 + fr, h = u.pn >> 1; LAS float* sb = st + (u.seq & 1) * 512;
        const int row0 = u.pm * BM + wr * 64 + fr, col0 = u.pn * BM + wc * 32 + 8 * fq;
        u32x4 ob[2][2];
#pragma unroll
        for (int m = 0; m < 2; ++m)
#pragma unroll
            for (int bj = 0; bj < 2; ++bj) ob[m][bj] = *(const u32x4*)(OR + (size_t)(row0 + m * 16) * RVW + col0 + bj * HALF);
        f32x4 gv[2][2];
#pragma unroll
        for (int bj = 0; bj < 2; ++bj)
#pragma unroll
            for (int n = 0; n < 2; ++n) gv[bj][n] = *(const f32x4*)(gng + col0 + bj * HALF + 4 * n);
        if (tid < 256) { const float* p = SP + ((size_t)(u.pm * BM + tid) * 16 + h) * 16; float s1 = 0.f, s2 = 0.f;
#pragma unroll
            for (int k = 0; k < 4; ++k) { const f32x4 t = *(const f32x4*)(p + 4 * k); s1 += t[0] + t[2]; s2 += t[1] + t[3]; }
            const float mean = s1 * (1.0f / 512.0f), var = fmaxf(s2 * (1.0f / 512.0f) - mean * mean, 0.f);
            sb[2 * tid] = mean; sb[2 * tid + 1] = 1.0f / sqrtf(var + GN_EPS); }
        asm volatile("s_waitcnt lgkmcnt(0)" ::: "memory"); __builtin_amdgcn_s_barrier(); asm volatile("" ::: "memory");
#pragma unroll
        for (int am = 0; am < 4; ++am) { const int ai = am >> 1, m0 = 2 * (am & 1); u32x4 oc[2][2];
#pragma unroll
            for (int m = 0; m < 2; ++m)
#pragma unroll
                for (int bj = 0; bj < 2; ++bj) oc[m][bj] = ob[m][bj];
            if (am < 3) { const int an = am + 1, ain = an >> 1, mn = 2 * (an & 1);
#pragma unroll
                for (int m = 0; m < 2; ++m)
#pragma unroll
                    for (int bj = 0; bj < 2; ++bj) ob[m][bj] = *(const u32x4*)(OR + (size_t)(row0 + ain * HALF + (mn + m) * 16) * RVW + col0 + bj * HALF); }
#pragma unroll
            for (int mm = 0; mm < 2; ++mm) { const int m = m0 + mm; const int r = ai * HALF + wr * 64 + m * 16 + fr; const float mean = sb[2 * r], rstd = sb[2 * r + 1];
                const size_t roff = (size_t)(row0 + ai * HALF + m * 16) * RVW + col0;
#pragma unroll
                for (int bj = 0; bj < 2; ++bj) { const u32x4 ov = oc[mm][bj];
                    const float ox[8] = {bf_lo(ov.x), bf_hi(ov.x), bf_lo(ov.y), bf_hi(ov.y), bf_lo(ov.z), bf_hi(ov.z), bf_lo(ov.w), bf_hi(ov.w)}; float a2[8];
#pragma unroll
                    for (int n = 0; n < 2; ++n)
#pragma unroll
                        for (int jx = 0; jx < 4; ++jx) { const float g = acc[ai][bj][m][n][jx]; const float sg = g * fast_rcp(1.f + fast_exp2(-1.4426950408889634f * g));
                            a2[4 * n + jx] = sg * ((ox[4 * n + jx] - mean) * rstd * gv[bj][n][jx]); }
                    u32x4 w; w.x = cvt_pk_bf16(a2[0], a2[1]); w.y = cvt_pk_bf16(a2[2], a2[3]); w.z = cvt_pk_bf16(a2[4], a2[5]); w.w = cvt_pk_bf16(a2[6], a2[7]);
                    *(u32x4*)(OW + roff + bj * HALF) = w; } } }
    }
};
struct EpiZ {
    static constexpr bool PERM = true; static constexpr bool WIDE = false; static constexpr bool ACC_BIAS = false;
    bf16_t* Y; const float* bias; const float* gate;
    __device__ __forceinline__ void operator()(const f32x4 (&acc)[2][2][4][2], const Unit& u, int wr, int wc, int fr, int fq) const {
        const int row0 = u.pm * BM + wr * 64 + fr, col0 = u.pn * BM + wc * 32 + 8 * fq; const float* gp = gate + (size_t)(u.pm >> 4) * 6 * D;
        f32x4 bv[2][2], gv[2][2];
#pragma unroll
        for (int bj = 0; bj < 2; ++bj)
#pragma unroll
            for (int n = 0; n < 2; ++n) { if (bias) bv[bj][n] = *(const f32x4*)(bias + col0 + bj * HALF + 4 * n); else bv[bj][n] = zero4(); gv[bj][n] = *(const f32x4*)(gp + col0 + bj * HALF + 4 * n) + 1.0f; }
#pragma unroll
        for (int ai = 0; ai < 2; ++ai)
#pragma unroll
            for (int m = 0; m < 4; ++m) { bf16_t* rowp = Y + (size_t)(row0 + ai * HALF + m * 16) * D + col0;
#pragma unroll
                for (int bj = 0; bj < 2; ++bj) { const f32x4 v0 = gv[bj][0] * (acc[ai][bj][m][0] + bv[bj][0]), v1 = gv[bj][1] * (acc[ai][bj][m][1] + bv[bj][1]);
                    u32x4 w; w.x = cvt_pk_bf16(v0[0], v0[1]); w.y = cvt_pk_bf16(v0[2], v0[3]); w.z = cvt_pk_bf16(v1[0], v1[1]); w.w = cvt_pk_bf16(v1[2], v1[3]);
                    *(u32x4*)(rowp + bj * HALF) = w; } }
    }
};
struct EpiGU {
    static constexpr bool PERM = true; static constexpr bool WIDE = false; static constexpr bool ACC_BIAS = false;
    bf16_t* H; const float* bgu;
    __device__ __forceinline__ void operator()(const f32x4 (&acc)[2][2][4][2], const Unit& u, int wr, int wc, int fr, int fq) const {
        const int row0 = u.pm * BM + wr * 64 + fr, fcol = u.pn * 128 + wc * 32 + 8 * fq; const float* bp = bgu + u.e * GUW;
        f32x4 bg[2], bu[2];
#pragma unroll
        for (int n = 0; n < 2; ++n) { bg[n] = *(const f32x4*)(bp + fcol + 4 * n); bu[n] = *(const f32x4*)(bp + EFF + fcol + 4 * n); }
#pragma unroll
        for (int ai = 0; ai < 2; ++ai)
#pragma unroll
            for (int m = 0; m < 4; ++m) { const int row = row0 + ai * HALF + m * 16; float o[8];
#pragma unroll
                for (int n = 0; n < 2; ++n) { const f32x4 g4 = acc[ai][0][m][n] + bg[n], u4 = acc[ai][1][m][n] + bu[n];
#pragma unroll
                    for (int j = 0; j < 4; ++j) { const float g = fminf(g4[j], 7.0f), up = fminf(fmaxf(u4[j], -7.0f), 7.0f);
                        o[4 * n + j] = (up + 1.0f) * g * fast_rcp(1.0f + fast_exp2(-1.702f * 1.4426950408889634f * g)); } }
                u32x4 w; w.x = cvt_pk_bf16(o[0], o[1]); w.y = cvt_pk_bf16(o[2], o[3]); w.z = cvt_pk_bf16(o[4], o[5]); w.w = cvt_pk_bf16(o[6], o[7]);
                *(u32x4*)(H + (size_t)row * EFF + fcol) = w; }
    }
};
struct EpiDown {
    static constexpr bool PERM = true; static constexpr bool WIDE = true; static constexpr bool ACC_BIAS = true;
    unsigned char* Y; const float* bdn;
    __device__ __forceinline__ void bias_load(const Unit& u, int wc, int fq, f32x4 (&bv)[2][2]) const {
        const float* bp = bdn + (size_t)u.e * D + u.pn * BM + wc * 64 + 16 * fq;
#pragma unroll
        for (int bj = 0; bj < 2; ++bj)
#pragma unroll
            for (int n = 0; n < 2; ++n) bv[bj][n] = *(const f32x4*)(bp + 8 * bj + 4 * n);
    }
    __device__ __forceinline__ void bias_load_untracked(const Unit& u, int wc, int fq, f32x4 (&bv)[2][2]) const {
        const float* bp = bdn + (size_t)u.e * D + u.pn * BM + wc * 64 + 16 * fq;
        asm volatile("global_load_dwordx4 %0, %4, off\n\tglobal_load_dwordx4 %1, %4, off offset:16\n\tglobal_load_dwordx4 %2, %4, off offset:32\n\tglobal_load_dwordx4 %3, %4, off offset:48"
                     : "=&v"(bv[0][0]), "=&v"(bv[0][1]), "=&v"(bv[1][0]), "=&v"(bv[1][1]) : "v"(bp) : "memory");
    }
    static constexpr int NSTORE = 8;
    __device__ __forceinline__ void operator()(const f32x4 (&acc)[2][2][4][2], const Unit& u, int wr, int wc, int fr, int fq) const {
        const int row0 = u.pm * BM + wr * 64 + fr, col0 = u.pn * BM + wc * 64 + 16 * fq;
#pragma unroll
        for (int ai = 0; ai < 2; ++ai)
#pragma unroll
            for (int m = 0; m < 4; ++m) { unsigned char* rowp = Y + (size_t)(row0 + ai * HALF + m * 16) * D + col0;
                int w[4];
#pragma unroll
                for (int bj = 0; bj < 2; ++bj) { f32x4 v0 = acc[ai][bj][m][0] * YP_SCALE, v1 = acc[ai][bj][m][1] * YP_SCALE;
#pragma unroll
                    for (int jx = 0; jx < 4; ++jx) { v0[jx] = __builtin_amdgcn_fmed3f(v0[jx], -448.0f, 448.0f); v1[jx] = __builtin_amdgcn_fmed3f(v1[jx], -448.0f, 448.0f); }
                    int w0 = 0, w1 = 0; w0 = __builtin_amdgcn_cvt_pk_fp8_f32(v0[0], v0[1], w0, false); w0 = __builtin_amdgcn_cvt_pk_fp8_f32(v0[2], v0[3], w0, true);
                    w1 = __builtin_amdgcn_cvt_pk_fp8_f32(v1[0], v1[1], w1, false); w1 = __builtin_amdgcn_cvt_pk_fp8_f32(v1[2], v1[3], w1, true);
                    w[2 * bj] = w0; w[2 * bj + 1] = w1; }
                *(u32x4*)rowp = (u32x4){(unsigned)w[0], (unsigned)w[1], (unsigned)w[2], (unsigned)w[3]}; }
    }
};
struct GuOrder {
    static constexpr bool SKIP = true;
    int G, c, L0, L1; const LAS int* ts; const LAS int* cn; const int* rows; const bf16_t* U; const bf16_t* W;
    __device__ __forceinline__ bool next(int i, Unit& u) const {
        const int L = L0 + i * G + c; if (L >= L1) return false;
        const int tg = (__builtin_amdgcn_readfirstlane(ts[480 + (L >> 1)]) >> 20) & 255, e = __builtin_amdgcn_readfirstlane(ts[480 + tg]) & 255, rt = tg - __builtin_amdgcn_readfirstlane(ts[e]);
        const int left = __builtin_amdgcn_readfirstlane(cn[e]) - rt * BM;
        u = Unit{tg, L & 1, e, rt, left < BM ? left : BM, i}; return true;
    }
    __device__ __forceinline__ const char* a_base(const Unit&) const { return (const char*)U; }
    __device__ __forceinline__ const char* b_base(const Unit& u) const { return (const char*)W + ((size_t)(u.e * GUW + u.pn * BM)) * D * 2; }
    __device__ __forceinline__ int row_token(const Unit& u, int r) const { return rows[u.e * ECAP + (r < u.valid ? u.rt * BM + r : 0)]; }
};
struct DownOrder {
    static constexpr bool SKIP = true;
    int G, c, D0, D1, nlate; const LAS int* ts; const LAS int* cn; const bf16_t* Hb; const bf16_t* W;
    static constexpr int PRE = 7;
    __device__ __forceinline__ bool next(int i, Unit& u) const {
        const int NL = G - nlate; int L;
        if (c < nlate) L = D0 + PRE * NL + i * G + c;
        else L = D0 + (i < PRE ? i * NL + (c - nlate) : PRE * NL + (i - PRE) * G + c);
        if (nlate == 0) L = D0 + i * G + c;
        if (L >= D1) return false;
        const int tg = (__builtin_amdgcn_readfirstlane(ts[480 + (L >> 4)]) >> 20) & 255, e = __builtin_amdgcn_readfirstlane(ts[480 + tg]) & 255, rt = tg - __builtin_amdgcn_readfirstlane(ts[e]);
        const int left = __builtin_amdgcn_readfirstlane(cn[e]) - rt * BM;
        u = Unit{tg, L & 15, e, rt, left < BM ? left : BM, i}; return true;
    }
    __device__ __forceinline__ const char* a_base(const Unit& u) const { return (const char*)Hb + (size_t)u.pm * BM * EFF * 2; }
    __device__ __forceinline__ const char* b_base(const Unit& u) const { return (const char*)W + ((size_t)u.e * D + u.pn * BM) * EFF * 2; }
    __device__ __forceinline__ int row_token(const Unit&, int r) const { return r; }
};
}

#define XB_TMO      128
#define XB_XCNT(j)  (256  + 64 * (j))
#define XB_XSUB(j)  (1280 + 64 * (j))
#define XB_XGEN(j)  (2304 + 64 * (j))
#define XB_TOP      3328
#define XB_TOPGEN   3392
#define XCD_BAR_WORDS 3456
#define XB_SPIN_CAP (1u << 18)
__device__ __forceinline__ unsigned xb_ld(unsigned* p)              { return __hip_atomic_load(p, __ATOMIC_RELAXED, __HIP_MEMORY_SCOPE_AGENT); }
__device__ __forceinline__ unsigned xb_add(unsigned* p, unsigned v) { return __hip_atomic_fetch_add(p, v, __ATOMIC_RELAXED, __HIP_MEMORY_SCOPE_AGENT); }
__device__ __forceinline__ unsigned xb_xcc_id() { return (unsigned)__builtin_amdgcn_s_getreg((3 << 11) | 20) & 0xFu; }
#define XB_SPIN(cond, bar) do { unsigned _sp = 0; while (cond) { __builtin_amdgcn_s_sleep(1); \
    if ((++_sp & 255u) == 0u) { if (xb_ld(&(bar)[XB_TMO])) break; if (_sp > XB_SPIN_CAP) { atomicAdd(&(bar)[XB_TMO], 1u); break; } } } } while (0)
struct XcdBarrier { unsigned* bar; unsigned x; volatile LAS unsigned* st; };
__device__ __forceinline__ XcdBarrier xcd_barrier_post(unsigned* bar, volatile LAS unsigned* st) {
    XcdBarrier b; b.bar = bar; b.x = xb_xcc_id(); b.st = st;
    if (threadIdx.x == 0) (void)xb_add(&bar[XB_XCNT(b.x)], 1u);
    return b;
}
__device__ __forceinline__ void xcd_barrier_complete(unsigned* bar, unsigned x, unsigned& nloc, unsigned& nx) {
    const unsigned G = gridDim.x * gridDim.y * gridDim.z;
    unsigned sum, cnt, mine, sp = 0u;
    for (;;) {
        sum = 0u; cnt = 0u; mine = 0u;
#pragma unroll
        for (unsigned j = 0; j < 16; ++j) { const unsigned c = xb_ld(&bar[XB_XCNT(j)]); sum += c; cnt += (c > 0u) ? 1u : 0u; mine = (j == x) ? c : mine; }
        if (sum == G) break;
        __builtin_amdgcn_s_sleep(1);
        if ((++sp & 255u) == 0u) { if (xb_ld(&bar[XB_TMO])) break; if (sp > XB_SPIN_CAP) { atomicAdd(&bar[XB_TMO], 1u); break; } }
    }
    nloc = mine > 0u ? mine : 1u; nx = cnt > 0u ? cnt : 1u;
}
__device__ __forceinline__ void xcd_barrier(const XcdBarrier& b, const int tid) {
    asm volatile("s_waitcnt vmcnt(0)" ::: "memory");
    __syncthreads();
    if (tid == 0) {
        unsigned* bar = b.bar;
        __builtin_amdgcn_s_waitcnt(0);
        unsigned nloc = b.st[0], nx = b.st[1];
        if (nloc == 0u) { xcd_barrier_complete(bar, b.x, nloc, nx); b.st[0] = nloc; b.st[1] = nx; }
        const unsigned old = xb_add(&bar[XB_XSUB(b.x)], 1u);
        const unsigned gen = old / nloc;
        if (old + 1u == (gen + 1u) * nloc) {
            __builtin_amdgcn_fence(__ATOMIC_RELEASE, "agent");
            asm volatile("s_waitcnt vmcnt(0)" ::: "memory");
            const unsigned og = xb_add(&bar[XB_TOP], 1u);
            const unsigned tg = og / nx;
            if (og + 1u == (tg + 1u) * nx) xb_add(&bar[XB_TOPGEN], 1u);
            else XB_SPIN(xb_ld(&bar[XB_TOPGEN]) == tg, bar);
            __builtin_amdgcn_fence(__ATOMIC_ACQUIRE, "agent");
            xb_add(&bar[XB_XGEN(b.x)], 1u);
            asm volatile("s_waitcnt vmcnt(0)" ::: "memory");
        } else {
            XB_SPIN(xb_ld(&bar[XB_XGEN(b.x)]) == gen, bar);
            __builtin_amdgcn_fence(__ATOMIC_ACQUIRE, "agent");
            asm volatile("s_waitcnt vmcnt(0)" ::: "memory");
        }
    }
    __syncthreads();
}

struct Args {
    const float* x; const float* c; const int* pos; const float* mod_w; const float* mod_b; const float* mod_layer; const float* ln_gain; const float* ln_bias;
    const float* w_qkv; const float* b_qkv; const float* sinks; const float* w_oa; const float* b_oa; const float* w_ret; const float* gn_gain; const float* w_or;
    const float* router_w; const float* router_b; const float* w_gu; const float* b_gu; const float* w_dn; const float* b_dn;
    float* out; unsigned char* ws; int ph_lo, ph_hi, use_bar, k_dn;
};
typedef const __attribute__((address_space(4))) Args CArgs;

__device__ __forceinline__ void transpose_item(const float* W, int K, int N, bf16_t* WT, int kb, int n0s, int n0d, bool rp, LAS float* scr, int lane) {
    const int k0 = 64 * kb;
    f32x4 tv[8];
#pragma unroll
    for (int i = 0; i < 8; ++i) tv[i] = __builtin_nontemporal_load((const f32x4*)(W + (size_t)(k0 + 8 * i + (lane >> 3)) * N + n0s + 4 * (lane & 7)));
#pragma unroll
    for (int i = 0; i < 8; ++i) { LAS float* d = scr + (8 * i + (lane >> 3)) * 33 + 4 * (lane & 7); d[0] = tv[i][0]; d[1] = tv[i][1]; d[2] = tv[i][2]; d[3] = tv[i][3]; }
    asm volatile("s_waitcnt lgkmcnt(0)" ::: "memory");
    const int cch = lane & 7;
#pragma unroll
    for (int j = 0; j < 4; ++j) { const int n = (lane >> 3) + 8 * j; int ns = n;
        if (rp && n < 16) ns = (n & 3) | ((n & 4) << 1) | ((n & 8) >> 1);
        const LAS float* s = scr + (8 * cch) * 33 + ns;
        u32x4 o; o.x = cvt_pk_bf16(s[0 * 33], s[1 * 33]); o.y = cvt_pk_bf16(s[2 * 33], s[3 * 33]); o.z = cvt_pk_bf16(s[4 * 33], s[5 * 33]); o.w = cvt_pk_bf16(s[6 * 33], s[7 * 33]);
        __builtin_nontemporal_store(o, (u32x4*)(WT + (size_t)(n0d + n) * K + k0 + 8 * cch)); }
    asm volatile("s_waitcnt lgkmcnt(0)" ::: "memory");
}
__device__ __forceinline__ float silu_f(float v) { return v / (1.0f + __expf(-v)); }

__device__ __forceinline__ void prep_items(CArgs& a, LAS unsigned char* lds, int wave, int lane, int worker, int nworkers, int mode) {
    bf16_t* Wb = (bf16_t*)(a.ws + WS_W);
    LAS float* scr = (LAS float*)(lds + wave * 16384);
    constexpr int I_QKV = 64 * 160, I_OA = 64 * 128, I_RET = 64 * 768, I_OR = 128 * 128, I_GU = 64 * 16, I_DN = 4 * 128;
    constexpr int E_QKV = 2 * I_QKV, E_OA = E_QKV + 2 * I_OA, E_RET = E_OA + 2 * I_RET, E_OR = E_RET + 2 * I_OR, E_GU = E_OR + 128 * I_GU, E_DN = E_GU + 128 * I_DN;
    constexpr int SIDE = 8192;
    const int nq = mode == 0 ? E_DN : SIDE;
    for (int q0 = worker; q0 < nq; q0 += nworkers) {
        int it = q0;
        if (mode == 0) { if ((it >= E_QKV + I_OA && it < E_QKV + I_OA + SIDE) || (it >= E_RET + I_OR && it < E_RET + I_OR + SIDE)) continue; }
        else if (mode == 1) it = E_QKV + I_OA + q0;
        else it = E_RET + I_OR + q0;
        if (it < E_QKV) { const int j = it / I_QKV, r = it % I_QKV, kb = r / 160, nb = r % 160; const int n0 = 32 * nb;
            transpose_item(a.w_qkv + (size_t)j * D * QKVN, D, QKVN, Wb + (W_QKV / 2) + (size_t)j * QKVN * D, kb, n0, n0, (n0 < 4608) && ((n0 & 63) == 0), scr, lane); }
        else if (it < E_OA) { const int q = it - E_QKV, j = q / I_OA, r = q % I_OA, kb = r / 128, nb = r % 128;
            transpose_item(a.w_oa + (size_t)j * D * D, D, D, Wb + (W_OA / 2) + (size_t)j * D * D, kb, 32 * nb, 32 * nb, false, scr, lane); }
        else if (it < E_RET) { const int q = it - E_OA, j = q / I_RET, r = q % I_RET, kb = r / 768, nb = r % 768;
            transpose_item(a.w_ret + (size_t)j * D * RETN, D, RETN, Wb + (W_RET / 2) + (size_t)j * RETN * D, kb, 32 * nb, 32 * nb, false, scr, lane); }
        else if (it < E_OR) { const int q = it - E_RET, j = q / I_OR, r = q % I_OR, kb = r / 128, nb = r % 128;
            transpose_item(a.w_or + (size_t)j * RVW * D, RVW, D, Wb + (W_OR / 2) + (size_t)j * D * RVW, kb, 32 * nb, 32 * nb, false, scr, lane); }
        else if (it < E_GU) { const int q = it - E_OR, mi = q / I_GU, r = q % I_GU, kb = r / 16, nb = r % 16;
            const int rowd = 32 * nb, tt = rowd >> 8, p = rowd & 255, bj = p >> 7, qq = p & 127; const int cols = bj * 256 + tt * 128 + qq;
            transpose_item(a.w_gu + (size_t)mi * D * GUW, D, GUW, Wb + (W_GU / 2) + (size_t)mi * GUW * D, kb, cols, rowd, false, scr, lane); }
        else { const int q = it - E_GU, mi = q / I_DN, r = q % I_DN, kb = r / 128, nb = r % 128;
            transpose_item(a.w_dn + (size_t)mi * EFF * D, EFF, D, Wb + (W_DN / 2) + (size_t)mi * D * EFF, kb, 32 * nb, 32 * nb, false, scr, lane); }
    }
}

__device__ __forceinline__ void phase_prep(CArgs& a, LAS unsigned char* lds, int G, int c, int wv) {
    const int tid = opaque_tid(wv), lane = tid & 63, wave = __builtin_amdgcn_readfirstlane(tid >> 6);
    const int gw = c * 8 + wave, NGW = G * 8;
    unsigned char* ws = a.ws;
    { float* modp = (float*)(ws + WS_MODP); LAS float* sl = (LAS float*)(lds + wave * 16384);
      for (int task = gw; task < 192 * 32; task += NGW) { const int cg = task % 192, kp = task / 192; const int col = cg * 128 + 2 * lane;
#pragma unroll
          for (int j = 0; j < 2; ++j) { const int k = kp * 128 + lane + 64 * j; sl[lane + 64 * j] = silu_f(a.c[k]); sl[128 + lane + 64 * j] = silu_f(a.c[D + k]); }
          asm volatile("s_waitcnt lgkmcnt(0)" ::: "memory");
          f32x2 a0 = {0.f, 0.f}, a1 = {0.f, 0.f};
#pragma unroll 16
          for (int kk = 0; kk < 128; ++kk) { const int k = kp * 128 + kk; const f32x2 w = __builtin_nontemporal_load((const f32x2*)(a.mod_w + (size_t)k * 24576 + col));
              const float s0 = sl[kk], s1 = sl[128 + kk]; a0 += w * s0; a1 += w * s1; }
          *(f32x2*)(modp + ((size_t)kp * 2 + 0) * 24576 + col) = a0; *(f32x2*)(modp + ((size_t)kp * 2 + 1) * 24576 + col) = a1;
          asm volatile("s_waitcnt lgkmcnt(0)" ::: "memory"); } }
    { const int gt = gw * 64 + lane, NT = NGW * 64;
      float* cosA = (float*)(ws + WS_CSA); float* sinA = cosA + T * 8; float* csR = (float*)(ws + WS_CSR); float* bq = (float*)(ws + WS_BQKV);
      { const float inv = powf(500000.0f, -(float)(2 * (gt & 7)) / 16.0f);
        for (int i = gt; i < T * 8; i += NT) { const int tok = i >> 3; const float ang = (float)a.pos[tok] * inv; float sn_, cs_; sincosf(ang, &sn_, &cs_); cosA[i] = cs_; sinA[i] = sn_; } }
      { const float inv = powf(10000.0f, -((float)(gt & 127) / 127.0f));
        for (int i = gt; i < T * 128; i += NT) { const int tok = i >> 7; const float ang = (float)a.pos[tok] * inv; float sn_, cs_; sincosf(ang, &sn_, &cs_); *(f32x2*)(csR + 2 * (size_t)i) = (f32x2){cs_, sn_}; } }
      for (int i = gt; i < 2 * QKVN; i += NT) { const int j = i / QKVN, n = i % QKVN; int ns = n; const int p = n & 63;
          if (n < 4608 && p < 16) ns = (n & ~15) | (p & 3) | ((p & 4) << 1) | ((p & 8) >> 1);
          bq[i] = a.b_qkv[j * QKVN + ns]; } }
    prep_items(a, lds, wave, lane, gw, NGW, 0);
}
__device__ __forceinline__ void phase_modreduce(CArgs& a, int G, int c, int wv) {
    const float* modp = (const float*)(a.ws + WS_MODP); float* modL = (float*)(a.ws + WS_MODL);
    const int tid = opaque_tid(wv);
    for (int o = c * 512 + tid; o < 2 * 24576; o += G * 512) { const int b = o / 24576, col = o % 24576; float s = a.mod_b[col];
        for (int kp = 0; kp < 32; ++kp) s += modp[((size_t)kp * 2 + b) * 24576 + col];
#pragma unroll
        for (int l = 0; l < NLAYER; ++l) modL[((size_t)l * 2 + b) * 24576 + col] = s + a.mod_layer[(size_t)l * 24576 + col]; }
}
__device__ __forceinline__ void store_u_row(const f32x4 (&xv)[16], const float* shift, const float* scale, bf16_t* urow, int lane) {
#pragma unroll
    for (int jj = 0; jj < 16; ++jj) { const int col = 256 * jj + 4 * lane; const f32x4 sc = *(const f32x4*)(scale + col) + 1.0f, sh = *(const f32x4*)(shift + col);
        const f32x4 u = xv[jj] * sc + sh; u32x2 w; w.x = cvt_pk_bf16(u[0], u[1]); w.y = cvt_pk_bf16(u[2], u[3]); *(u32x2*)(urow + col) = w; }
}
__device__ __forceinline__ void phase_u0(CArgs& a, LAS unsigned char* lds, int G, int c, int wv) {
    const int tid = opaque_tid(wv), lane = tid & 63, wave = __builtin_amdgcn_readfirstlane(tid >> 6); const float* modL = (const float*)(a.ws + WS_MODL); bf16_t* U = (bf16_t*)(a.ws + WS_U);
    LAS float* TL = (LAS float*)lds;
    { unsigned short* t16 = (unsigned short*)(a.ws + WS_T16);
      for (int idx = c * 512 + tid; idx < NLAYER * 2 * D; idx += G * 512) { const int l = idx >> 13, b = (idx >> 12) & 1, col = idx & 4095; const float* mbp = modL + (size_t)(l * 2 + b) * 24576;
          const float tv4[4] = {a.ln_gain[(size_t)(l * 2) * D + col], a.ln_bias[(size_t)(l * 2) * D + col], 1.0f + mbp[4 * D + col], mbp[3 * D + col]};
          unsigned short* dst = t16 + ((((size_t)(l * 2 + b) * 8 + (col >> 9)) * 64 + ((col >> 3) & 63)) * 4) * 8 + (col & 7);
#pragma unroll
          for (int t = 0; t < 4; ++t) dst[t * 8] = (unsigned short)(cvt_pk_f16(tv4[t], 0.f) & 0xffffu); } }
    { f32x4 tvv[8];
#pragma unroll
      for (int i = 0; i < 8; ++i) { const int t = i >> 1, col = (i & 1) * 2048 + tid * 4; tvv[i] = (t < 2) ? *(const f32x4*)(modL + (size_t)t * 24576 + col) : *(const f32x4*)(modL + (size_t)(t - 2) * 24576 + D + col); }
#pragma unroll
      for (int i = 0; i < 8; ++i) { const int t = i >> 1, col = (i & 1) * 2048 + tid * 4; *(LAS f32x4*)(TL + t * D + col) = (t < 2) ? tvv[i] : tvv[i] + 1.0f; } }
    __syncthreads();
    for (int row = c * 8 + wave; row < T; row += G * 8) { const int b = row >> 12;
        f32x4 xv[16];
#pragma unroll
        for (int jj = 0; jj < 16; ++jj) xv[jj] = *(const f32x4*)(a.x + (size_t)row * D + 256 * jj + 4 * lane);
        unsigned so = (unsigned)(uintptr_t)(TL + b * D), co = (unsigned)(uintptr_t)(TL + (2 + b) * D); OPAQUE_S(so); OPAQUE_S(co);
        const LAS float* sp = (const LAS float*)(uintptr_t)so; const LAS float* cp = (const LAS float*)(uintptr_t)co; bf16_t* urow = U + (size_t)row * D;
#pragma unroll
        for (int jj = 0; jj < 16; ++jj) { const int col = 256 * jj + 4 * lane; const f32x4 u = xv[jj] * *(const LAS f32x4*)(cp + col) + *(const LAS f32x4*)(sp + col);
            u32x2 w; w.x = cvt_pk_bf16(u[0], u[1]); w.y = cvt_pk_bf16(u[2], u[3]); *(u32x2*)(urow + col) = w;
            u32x2 xh; xh.x = cvt_pk_f16(xv[jj][0], xv[jj][1]); xh.y = cvt_pk_f16(xv[jj][2], xv[jj][3]); __builtin_nontemporal_store(xh, (u32x2*)((bf16_t*)(a.ws + WS_XB) + (size_t)row * D + col)); } }
}
template <bool C8> __device__ __forceinline__ int lncol(int jj, int lane) { return C8 ? 512 * (jj >> 1) + 8 * lane + 4 * (jj & 1) : 256 * jj + 4 * lane; }
template <bool C8 = false>
__device__ __forceinline__ void ln_row(f32x4 (&v)[16], const float* gain, const float* bias, int lane) {
    float s = 0.f;
#pragma unroll
    for (int jj = 0; jj < 16; ++jj) s += (v[jj][0] + v[jj][1]) + (v[jj][2] + v[jj][3]);
    const float mean = wave_sum(s, lane) * (1.0f / D); float q = 0.f;
#pragma unroll
    for (int jj = 0; jj < 16; ++jj) { v[jj] = v[jj] - mean; q += (v[jj][0] * v[jj][0] + v[jj][1] * v[jj][1]) + (v[jj][2] * v[jj][2] + v[jj][3] * v[jj][3]); }
    const float rstd = 1.0f / sqrtf(wave_sum(q, lane) * (1.0f / D) + LN_EPS);
#pragma unroll
    for (int jj = 0; jj < 16; ++jj) { const int col = lncol<C8>(jj, lane); v[jj] = v[jj] * rstd * *(const f32x4*)(gain + col) + *(const f32x4*)(bias + col); }
}
template <bool C8 = false>
__device__ __forceinline__ void ln_row_lds(f32x4 (&v)[16], const LAS float* gain, const LAS float* bias, int lane) {
    unsigned go = (unsigned)(uintptr_t)gain, bo = (unsigned)(uintptr_t)bias; OPAQUE_S(go); OPAQUE_S(bo);
    const LAS float* gp = (const LAS float*)(uintptr_t)go; const LAS float* bp = (const LAS float*)(uintptr_t)bo;
    float s = 0.f;
#pragma unroll
    for (int jj = 0; jj < 16; ++jj) s += (v[jj][0] + v[jj][1]) + (v[jj][2] + v[jj][3]);
    const float mean = wave_sum(s, lane) * (1.0f / D); float q = 0.f;
#pragma unroll
    for (int jj = 0; jj < 16; ++jj) { v[jj] = v[jj] - mean; q += (v[jj][0] * v[jj][0] + v[jj][1] * v[jj][1]) + (v[jj][2] * v[jj][2] + v[jj][3] * v[jj][3]); }
    const float rstd = 1.0f / sqrtf(wave_sum(q, lane) * (1.0f / D) + LN_EPS);
#pragma unroll
    for (int jj = 0; jj < 16; ++jj) { const int col = lncol<C8>(jj, lane); v[jj] = v[jj] * rstd * *(const LAS f32x4*)(gp + col) + *(const LAS f32x4*)(bp + col); }
}
__device__ __forceinline__ void phase_ln1(CArgs& a, LAS unsigned char* lds, int layer, int G, int c, int wv, bool dry) {
    const bf16_t* Xb = (const bf16_t*)(a.ws + WS_XB); bf16_t* Xw = (bf16_t*)(a.ws + WS_XB);
    const int tid = opaque_tid(wv), lane = tid & 63, wave = __builtin_amdgcn_readfirstlane(tid >> 6);
    const bf16_t* Yp = (const bf16_t*)(a.ws + WS_Z); bf16_t* U = (bf16_t*)(a.ws + WS_U); const float* modL = (const float*)(a.ws + WS_MODL) + (size_t)layer * 2 * 24576;
    const float* gain = a.ln_gain + ((size_t)layer * 2 + 0) * D; const float* bias = a.ln_bias + ((size_t)layer * 2 + 0) * D;
    const float* rw = a.router_w + (size_t)layer * D * NEXP; const float* rb = a.router_b + layer * NEXP;
    unsigned* cnt = (unsigned*)(a.ws + WS_CTL) + CW_CNT + layer * 64;
    int* rows = (int*)(a.ws + WS_ROWS); int* tk_e = (int*)(a.ws + WS_TK); int* tk_pos = tk_e + T * 4; float* tk_w = (float*)(tk_pos + T * 4);
    constexpr int UP = 4352;
    LAS float* uL = (LAS float*)lds;
    LAS float* pL = (LAS float*)(lds + 8 * UP * 4);
    LAS float* lg = (LAS float*)(lds + 8 * UP * 4 + 8192);
    const float rbv = rb[tid & 31];
    u32x4 yq[8], xq[8];
    { const int row = c * 8 + wave;
#pragma unroll
      for (int p = 0; p < 8; ++p) yq[p] = __builtin_nontemporal_load((const u32x4*)(Yp + (size_t)row * D + 512 * p + 8 * lane));
#pragma unroll
      for (int p = 0; p < 8; ++p) xq[p] = __builtin_nontemporal_load((const u32x4*)(Xb + (size_t)row * D + 512 * p + 8 * lane)); }
    for (int it = c; it < T / 8; it += G) {
        const int row = it * 8 + wave, b = row >> 12; const float* mb = modL + (size_t)b * 24576;
        f32x4 v[16];
        u32x4 tA[8], tB[8];
        typedef const __attribute__((address_space(1))) float* gfp_t; typedef const __attribute__((address_space(1))) f32x4* gf4p_t; typedef const __attribute__((address_space(1))) u32x4* gu4p_t;
        typedef const __attribute__((address_space(1))) char* gcp_t; const unsigned tvo = 64u * (unsigned)lane;
        gcp_t t16p = (gcp_t)(a.ws + WS_T16) + (size_t)((layer * 2 + b) * 8) * 4096;
#define LN1_TLOAD(t, hb) { gcp_t p0_ = t16p + 4096 * (2 * (hb)), p1_ = t16p + 4096 * (2 * (hb) + 1); OPAQUE_S(p0_); OPAQUE_S(p1_); \
            _Pragma("unroll") for (int q = 0; q < 4; ++q) { t[q] = *(gu4p_t)(p0_ + (size_t)tvo + 16 * q); t[4 + q] = *(gu4p_t)(p1_ + (size_t)tvo + 16 * q); } }
#define LN1_F16LO(q_) ((f32x4){h_lo((q_).x), h_hi((q_).x), h_lo((q_).y), h_hi((q_).y)})
#define LN1_F16HI(q_) ((f32x4){h_lo((q_).z), h_hi((q_).z), h_lo((q_).w), h_hi((q_).w)})
#define LN1_TUSE(t, hb) { _Pragma("unroll") for (int pp = 0; pp < 2; ++pp) { const int p = 2 * (hb) + pp, col = 512 * p + 8 * lane; \
            const f32x4 x0 = v[2 * p] * rstd * LN1_F16LO(t[4 * pp]) + LN1_F16LO(t[4 * pp + 1]), x1 = v[2 * p + 1] * rstd * LN1_F16HI(t[4 * pp]) + LN1_F16HI(t[4 * pp + 1]); \
            u32x4 wx; wx.x = cvt_pk_f16(x0[0], x0[1]); wx.y = cvt_pk_f16(x0[2], x0[3]); wx.z = cvt_pk_f16(x1[0], x1[1]); wx.w = cvt_pk_f16(x1[2], x1[3]); \
            *(u32x4*)((dry ? (bf16_t*)(a.ws + WS_ACT + ACT_SG) : Xw) + (size_t)row * D + col) = wx; \
            const f32x4 u0 = x0 * LN1_F16LO(t[4 * pp + 2]) + LN1_F16LO(t[4 * pp + 3]), u1 = x1 * LN1_F16HI(t[4 * pp + 2]) + LN1_F16HI(t[4 * pp + 3]); \
            u32x4 w; w.x = cvt_pk_bf16(u0[0], u0[1]); w.y = cvt_pk_bf16(u0[2], u0[3]); w.z = cvt_pk_bf16(u1[0], u1[1]); w.w = cvt_pk_bf16(u1[2], u1[3]); *(u32x4*)(U + (size_t)row * D + col) = w; \
            *(LAS f32x4*)(uL + wave * UP + col + 4 * (col >> 6)) = u0; *(LAS f32x4*)(uL + wave * UP + col + 4 + 4 * (col >> 6)) = u1; } }
        LN1_TLOAD(tA, 0)
        __builtin_amdgcn_sched_barrier(0);
#pragma unroll
        for (int p = 0; p < 8; ++p) { v[2 * p] = (f32x4){h_lo(xq[p].x), h_hi(xq[p].x), h_lo(xq[p].y), h_hi(xq[p].y)}; v[2 * p + 1] = (f32x4){h_lo(xq[p].z), h_hi(xq[p].z), h_lo(xq[p].w), h_hi(xq[p].w)}; }
#pragma unroll
        for (int p = 0; p < 8; ++p) { v[2 * p] = v[2 * p] * ALPHA + (f32x4){bf_lo(yq[p].x), bf_hi(yq[p].x), bf_lo(yq[p].y), bf_hi(yq[p].y)}; v[2 * p + 1] = v[2 * p + 1] * ALPHA + (f32x4){bf_lo(yq[p].z), bf_hi(yq[p].z), bf_lo(yq[p].w), bf_hi(yq[p].w)}; }
        __builtin_amdgcn_sched_barrier(0); LN1_TLOAD(tB, 1) __builtin_amdgcn_sched_barrier(0);
        float rstd; { float s_ = 0.f;
#pragma unroll
            for (int jj = 0; jj < 16; ++jj) s_ += (v[jj][0] + v[jj][1]) + (v[jj][2] + v[jj][3]);
            const float mean = wave_sum(s_, lane) * (1.0f / D); float q_ = 0.f;
#pragma unroll
            for (int jj = 0; jj < 16; ++jj) { v[jj] = v[jj] - mean; q_ += (v[jj][0] * v[jj][0] + v[jj][1] * v[jj][1]) + (v[jj][2] * v[jj][2] + v[jj][3] * v[jj][3]); }
            rstd = 1.0f / sqrtf(wave_sum(q_, lane) * (1.0f / D) + LN_EPS); }
        const int eg = tid & 7, ks = tid >> 3; gcp_t wp = (gcp_t)rw; f32x4 wA[8], wB[8]; const unsigned wvo = (unsigned)((ks * 64 * NEXP + 4 * eg) * 4);
        gcp_t wph = wp + 32 * NEXP * 4; OPAQUE_S(wp); OPAQUE_S(wph);
#define LN1_WLOAD(w, g) { _Pragma("unroll") for (int i = 0; i < 8; ++i) w[i] = *(gf4p_t)(((g) < 4 ? wp : wph) + (size_t)wvo + (8 * ((g) & 3) + i) * NEXP * 4); }
        __builtin_amdgcn_sched_barrier(0);
        LN1_TUSE(tA, 0) __builtin_amdgcn_sched_barrier(0);
        LN1_TLOAD(tA, 2) __builtin_amdgcn_sched_barrier(0); LN1_TUSE(tB, 1) __builtin_amdgcn_sched_barrier(0);
        LN1_TLOAD(tB, 3) __builtin_amdgcn_sched_barrier(0); LN1_TUSE(tA, 2) __builtin_amdgcn_sched_barrier(0);
        LN1_WLOAD(wA, 0) __builtin_amdgcn_sched_barrier(0); LN1_TUSE(tB, 3) __builtin_amdgcn_sched_barrier(0);
        __syncthreads();
        { f32x4 acc[8];
#pragma unroll
          for (int r = 0; r < 8; ++r) acc[r] = zero4();
          const LAS float* up = uL + ks * 68;
#define LN1_WUSE(w, g) { _Pragma("unroll") for (int s4 = 0; s4 < 2; ++s4) { _Pragma("unroll") for (int r = 0; r < 8; ++r) { const f32x4 uv = *(const LAS f32x4*)(up + r * UP + 8 * (g) + 4 * s4); \
              acc[r] = w[4 * s4 + 0] * uv[0] + acc[r]; acc[r] = w[4 * s4 + 1] * uv[1] + acc[r]; acc[r] = w[4 * s4 + 2] * uv[2] + acc[r]; acc[r] = w[4 * s4 + 3] * uv[3] + acc[r]; } } }
          LN1_WLOAD(wB, 1) __builtin_amdgcn_sched_barrier(0); LN1_WUSE(wA, 0) __builtin_amdgcn_sched_barrier(0);
          LN1_WLOAD(wA, 2) __builtin_amdgcn_sched_barrier(0); LN1_WUSE(wB, 1) __builtin_amdgcn_sched_barrier(0);
          LN1_WLOAD(wB, 3) __builtin_amdgcn_sched_barrier(0); LN1_WUSE(wA, 2) __builtin_amdgcn_sched_barrier(0);
          LN1_WLOAD(wA, 4) __builtin_amdgcn_sched_barrier(0); LN1_WUSE(wB, 3) __builtin_amdgcn_sched_barrier(0);
          LN1_WLOAD(wB, 5) __builtin_amdgcn_sched_barrier(0); LN1_WUSE(wA, 4) __builtin_amdgcn_sched_barrier(0);
          LN1_WLOAD(wA, 6) __builtin_amdgcn_sched_barrier(0); LN1_WUSE(wB, 5) __builtin_amdgcn_sched_barrier(0);
          LN1_WLOAD(wB, 7) __builtin_amdgcn_sched_barrier(0); LN1_WUSE(wA, 6) __builtin_amdgcn_sched_barrier(0);
          LN1_WUSE(wB, 7)
#pragma unroll
          for (int r = 0; r < 8; ++r)
#pragma unroll
              for (int jx = 0; jx < 4; ++jx) { float t = acc[r][jx]; t += shx(t, 8, lane); t += shx(t, 16, lane); t += shx(t, 32, lane); acc[r][jx] = t; }
          if (lane < 8) {
#pragma unroll
              for (int r = 0; r < 8; ++r) *(LAS f32x4*)(pL + (wave * 8 + r) * NEXP + 4 * eg) = acc[r]; } }
        { const int itn = it + G < T / 8 ? it + G : it, rown = itn * 8 + wave;
#pragma unroll
            for (int p = 0; p < 8; ++p) yq[p] = __builtin_nontemporal_load((const u32x4*)(Yp + (size_t)rown * D + 512 * p + 8 * lane));
#pragma unroll
            for (int p = 0; p < 8; ++p) xq[p] = __builtin_nontemporal_load((const u32x4*)(Xb + (size_t)rown * D + 512 * p + 8 * lane)); }
        __syncthreads();
        if (tid < 256) { const int r = tid >> 5, e = tid & 31; float s = rbv;
#pragma unroll
            for (int wq = 0; wq < 8; ++wq) s += pL[(wq * 8 + r) * NEXP + e];
            lg[r * NEXP + e] = s; }
        __syncthreads();
        if (!dry) {
            const int tok = it * 8 + wave; float val = lg[wave * NEXP + (lane & 31)]; float tv = 0.f, t0 = 0.f; int te = 0;
#pragma unroll
            for (int k = 0; k < 4; ++k) { float bv = val; int bi = lane & 31;
#pragma unroll
                for (int o = 1; o < 32; o <<= 1) { const float ov = shx(bv, o, lane); const int oi = __builtin_amdgcn_ds_bpermute((lane ^ o) << 2, bi); if (ov > bv || (ov == bv && oi < bi)) { bv = ov; bi = oi; } }
                if (k == 0) t0 = bv; if (lane == k) { tv = bv; te = bi; } if ((lane & 31) == bi) val = -3.0e38f; }
            float ex = (lane < 4) ? __expf(tv - t0) : 0.f; float den = ex; den += shx(den, 1, lane); den += shx(den, 2, lane);
            if (lane < 4) { const unsigned p = atomicAdd(cnt + te, 1u); rows[te * ECAP + (int)p] = tok; tk_e[tok * 4 + lane] = te; tk_pos[tok * 4 + lane] = (int)p; tk_w[tok * 4 + lane] = ex / den; } }
        __syncthreads();
    }
}
__device__ __forceinline__ int moe_tables(CArgs& a, LAS unsigned char* lds, int layer, int wv, bool reuse) {
    LAS int* ts = (LAS int*)(lds + LDSCTL_OFF); LAS int* cn = ts + 64;
    if (reuse) return ts[NEXP];
    const unsigned* cnt = (const unsigned*)(a.ws + WS_CTL) + CW_CNT + layer * 64;
    const int tid = opaque_tid(wv);
    __syncthreads();
    if (tid < NEXP) cn[tid] = (int)__hip_atomic_load(cnt + tid, __ATOMIC_RELAXED, __HIP_MEMORY_SCOPE_AGENT);
    __syncthreads();
    if (tid == 0) { int acc = 0; for (int e = 0; e < NEXP; ++e) { ts[e] = acc; acc += (cn[e] + 255) >> 8; } ts[NEXP] = acc; }
    __syncthreads();
    const int ntile = ts[NEXP];
    if (tid < MAXSLOT / 256) { int e = 0;
#pragma clang loop vectorize(disable)
        for (int k = 0; k < NEXP; ++k) if (tid >= ts[k + 1]) e = k + 1;
        e = e < NEXP ? e : NEXP - 1; int left = cn[e] - (tid - ts[e]) * 256; left = left < 256 ? left : 256; if (tid >= ntile) left = 0;
        ts[480 + tid] = e | (left << 8); }
    __syncthreads();
    int rank = 0;
    if (tid < ntile) { const int mine = (ts[480 + tid] >> 8) & 511;
#pragma unroll 1
        for (int j0 = 0; j0 < MAXSLOT / 256; j0 += 16) { int vv[16];
#pragma unroll
            for (int j = 0; j < 16; ++j) vv[j] = ts[480 + j0 + j];
#pragma unroll
            for (int j = 0; j < 16; ++j) { const int vj = (vv[j] >> 8) & 511; rank += (vj > mine || (vj == mine && j0 + j < tid)) ? 1 : 0; } } }
    __syncthreads();
    if (tid < ntile) ts[480 + rank] |= tid << 20;
    __syncthreads();
    return ntile;
}
__device__ __forceinline__ void phase_ln2(CArgs& a, LAS unsigned char* lds, int layer, int G, int c, int wv, bool dry, bool reuse_tab) {
    const int tid = opaque_tid(wv), lane = tid & 63, wave = __builtin_amdgcn_readfirstlane(tid >> 6);
    (void)moe_tables(a, lds, layer, wv, reuse_tab);
    const LAS int* ts = (const LAS int*)(lds + LDSCTL_OFF);
    const unsigned char* YP = (const unsigned char*)(a.ws + WS_ACT + ACT_YP); bf16_t* U = (bf16_t*)(a.ws + WS_U);
    const float* modL = (const float*)(a.ws + WS_MODL) + (size_t)layer * 2 * 24576; const float* modN = (const float*)(a.ws + WS_MODL) + (size_t)(layer + 1) * 2 * 24576;
    const float* gain = a.ln_gain + ((size_t)layer * 2 + 1) * D; const float* bias = a.ln_bias + ((size_t)layer * 2 + 1) * D; const bf16_t* Xb = (const bf16_t*)(a.ws + WS_XB);
    const int* tk_e = (const int*)(a.ws + WS_TK); const int* tk_pos = tk_e + T * 4; const float* tk_w = (const float*)(tk_pos + T * 4);
    LAS float* TL = (LAS float*)lds;
    { f32x4 tvv[16]; const bool hn = layer + 1 < NLAYER;
#pragma unroll
      for (int i = 0; i < 16; ++i) { const int t = i >> 1, col = (i & 1) * 2048 + tid * 4; const float* src;
          if (t == 0) src = gain + col; else if (t == 1) src = bias + col; else if (t < 4) src = modL + (size_t)(t - 2) * 24576 + 5 * D + col;
          else if (t < 6) src = (hn ? modN : modL) + (size_t)(t - 4) * 24576 + 0 * D + col; else src = (hn ? modN : modL) + (size_t)(t - 6) * 24576 + 1 * D + col;
          tvv[i] = *(const f32x4*)src; }
#pragma unroll
      for (int i = 0; i < 16; ++i) { const int t = i >> 1, col = (i & 1) * 2048 + tid * 4; f32x4 val = tvv[i];
          if (t == 2 || t == 3 || t >= 6) val = val + 1.0f;
          *(LAS f32x4*)(TL + t * D + col) = val; } }
    __syncthreads();
    int4 te4n, tp4n; f32x4 tw4n;
    { const int row0 = c * 8 + wave; if (row0 < T) { te4n = *(const int4*)(tk_e + row0 * 4); tp4n = *(const int4*)(tk_pos + row0 * 4); tw4n = *(const f32x4*)(tk_w + row0 * 4); } }
    for (int row = c * 8 + wave; row < T; row += G * 8) { const int b = row >> 12;
        f32x4 v[16];
        const int4 te4 = te4n, tp4 = tp4n; const f32x4 tw4 = tw4n;
        { const int rn = row + G * 8; if (rn < T) { te4n = *(const int4*)(tk_e + rn * 4); tp4n = *(const int4*)(tk_pos + rn * 4); tw4n = *(const f32x4*)(tk_w + rn * 4); } }
        const int tes[4] = {te4.x, te4.y, te4.z, te4.w}, tps[4] = {tp4.x, tp4.y, tp4.z, tp4.w};
        u32x2 yv[4][8];
#pragma unroll
        for (int k = 0; k < 4; ++k) { const unsigned char* yr = YP + ((size_t)ts[tes[k]] * 256 + tps[k]) * D + 8 * lane;
#pragma unroll
            for (int p = 0; p < 8; ++p) yv[k][p] = __builtin_nontemporal_load((const u32x2*)(yr + 512 * p)); }
        const f32x4 tws = tw4 * (1.0f / YP_SCALE);
#pragma unroll
        for (int p = 0; p < 8; ++p) { f32x4 t0 = zero4(), t1 = t0;
#pragma unroll
            for (int k = 0; k < 4; ++k) { const f32x2 a0 = __builtin_amdgcn_cvt_pk_f32_fp8((int)yv[k][p].x, false), a1 = __builtin_amdgcn_cvt_pk_f32_fp8((int)yv[k][p].x, true), b0 = __builtin_amdgcn_cvt_pk_f32_fp8((int)yv[k][p].y, false), b1 = __builtin_amdgcn_cvt_pk_f32_fp8((int)yv[k][p].y, true);
                t0 += (f32x4){a0[0], a0[1], a1[0], a1[1]} * tws[k]; t1 += (f32x4){b0[0], b0[1], b1[0], b1[1]} * tws[k]; }
            v[2 * p] = t0; v[2 * p + 1] = t1; }
        { unsigned go = (unsigned)(uintptr_t)(TL + (2 + b) * D); OPAQUE_S(go); const LAS float* gp = (const LAS float*)(uintptr_t)go;
          u32x4 xqa[8];
#pragma unroll
          for (int p = 0; p < 8; ++p) xqa[p] = __builtin_nontemporal_load((const u32x4*)(Xb + (size_t)row * D + 512 * p + 8 * lane));
          asm volatile("" ::: "memory");
#pragma unroll
          for (int p = 0; p < 8; ++p) { const u32x4 xq = xqa[p];
              v[2 * p] = (f32x4){h_lo(xq.x), h_hi(xq.x), h_lo(xq.y), h_hi(xq.y)} * ALPHA + *(const LAS f32x4*)(gp + 512 * p + 8 * lane) * v[2 * p];
              v[2 * p + 1] = (f32x4){h_lo(xq.z), h_hi(xq.z), h_lo(xq.w), h_hi(xq.w)} * ALPHA + *(const LAS f32x4*)(gp + 512 * p + 8 * lane + 4) * v[2 * p + 1]; } }
        ln_row_lds<true>(v, TL, TL + D, lane);
        if (layer + 1 == NLAYER) { float* xo = dry ? (float*)(a.ws + WS_Z) : a.out;
#pragma unroll
            for (int jj = 0; jj < 16; ++jj) __builtin_nontemporal_store(v[jj], (f32x4*)(xo + (size_t)row * D + lncol<true>(jj, lane))); }
        else { bf16_t* xo = dry ? (bf16_t*)(a.ws + WS_Z) : (bf16_t*)(a.ws + WS_XB);
#pragma unroll
            for (int p = 0; p < 8; ++p) { u32x4 w; w.x = cvt_pk_f16(v[2 * p][0], v[2 * p][1]); w.y = cvt_pk_f16(v[2 * p][2], v[2 * p][3]); w.z = cvt_pk_f16(v[2 * p + 1][0], v[2 * p + 1][1]); w.w = cvt_pk_f16(v[2 * p + 1][2], v[2 * p + 1][3]);
                *(u32x4*)(xo + (size_t)row * D + 512 * p + 8 * lane) = w; } }
        if (layer + 1 < NLAYER) { unsigned so = (unsigned)(uintptr_t)(TL + (4 + b) * D), co = (unsigned)(uintptr_t)(TL + (6 + b) * D); OPAQUE_S(so); OPAQUE_S(co);
            const LAS float* sp = (const LAS float*)(uintptr_t)so; const LAS float* cp = (const LAS float*)(uintptr_t)co; bf16_t* urow = U + (size_t)row * D;
#pragma unroll
            for (int p = 0; p < 8; ++p) { const int col = 512 * p + 8 * lane; const f32x4 u0 = v[2 * p] * *(const LAS f32x4*)(cp + col) + *(const LAS f32x4*)(sp + col), u1 = v[2 * p + 1] * *(const LAS f32x4*)(cp + col + 4) + *(const LAS f32x4*)(sp + col + 4);
                u32x4 w; w.x = cvt_pk_bf16(u0[0], u0[1]); w.y = cvt_pk_bf16(u0[2], u0[3]); w.z = cvt_pk_bf16(u1[0], u1[1]); w.w = cvt_pk_bf16(u1[2], u1[3]); *(u32x4*)(urow + col) = w; } }
    }
}

template <int O0, int O1>
__device__ __forceinline__ void tr_read8(unsigned base, s16x4 (&lo)[4], s16x4 (&hi)[4]) {
    asm volatile("ds_read_b64_tr_b16 %0, %8 offset:%9\n\tds_read_b64_tr_b16 %1, %8 offset:%10\n\tds_read_b64_tr_b16 %2, %8 offset:%11\n\tds_read_b64_tr_b16 %3, %8 offset:%12\n\t"
                 "ds_read_b64_tr_b16 %4, %8 offset:%13\n\tds_read_b64_tr_b16 %5, %8 offset:%14\n\tds_read_b64_tr_b16 %6, %8 offset:%15\n\tds_read_b64_tr_b16 %7, %8 offset:%16\n\ts_waitcnt lgkmcnt(0)"
                 : "=&v"(lo[0]), "=&v"(lo[1]), "=&v"(lo[2]), "=&v"(lo[3]), "=&v"(hi[0]), "=&v"(hi[1]), "=&v"(hi[2]), "=&v"(hi[3])
                 : "v"(base), "n"(O0), "n"(O0 + 32), "n"(O0 + 64), "n"(O0 + 96), "n"(O1), "n"(O1 + 32), "n"(O1 + 64), "n"(O1 + 96) : "memory");
}
template <int O0, int O1>
__device__ __forceinline__ void tr_read2(unsigned base, s16x4& lo, s16x4& hi) {
    asm volatile("ds_read_b64_tr_b16 %0, %2 offset:%3\n\tds_read_b64_tr_b16 %1, %2 offset:%4\n\ts_waitcnt lgkmcnt(0)" : "=&v"(lo), "=&v"(hi) : "v"(base), "n"(O0), "n"(O1) : "memory");
}
__device__ __forceinline__ bf16x8 cat4(s16x4 lo, s16x4 hi) { return __builtin_shufflevector(lo, hi, 0, 1, 2, 3, 4, 5, 6, 7); }

__device__ __forceinline__ void phase_attn(CArgs& a, LAS unsigned char* lds, int j, int G, int c, int wv) {
    const int tid = opaque_tid(wv), lane = tid & 63, wave = __builtin_amdgcn_readfirstlane(tid >> 6), fr = lane & 15, fq = lane >> 4, q4 = (lane & 15) >> 2, p4 = lane & 3;
    const bf16_t* QKV = (const bf16_t*)(a.ws + WS_ACT + ACT_QKV); bf16_t* O = (bf16_t*)(a.ws + WS_ACT + ACT_O);
    LAS unsigned char* Kl = lds; LAS unsigned char* Vl = lds + 256 * 144;
    const unsigned vbase = (unsigned)(uintptr_t)Vl;
    constexpr float SC = 0.125f * 1.4426950408889634f;
    for (int u = c; u < 512; u += G) {
        const int b = u >> 8, n = (u >> 3) & 31, kvh = u & 7;
        __syncthreads();
        { u32x4 kb4[4], vb4[4];
#pragma unroll
          for (int i = 0; i < 4; ++i) { const int id = tid + 512 * i, row = id >> 3, ch = id & 7, pos = n * 128 - 128 + row;
              const bf16_t* src = QKV + (size_t)(b * SEQ + (pos >= 0 ? pos : 0)) * QKVN + 4096 + kvh * 64 + ch * 8; kb4[i] = *(const u32x4*)src; vb4[i] = *(const u32x4*)(src + 512); }
#pragma unroll
          for (int i = 0; i < 4; ++i) { const int id = tid + 512 * i, row = id >> 3, ch = id & 7, pos = n * 128 - 128 + row;
              const u32x4 z = zero4u(); *(LAS u32x4*)(Kl + row * 144 + ch * 16) = pos >= 0 ? kb4[i] : z; *(LAS u32x4*)(Vl + row * 144 + ch * 16) = pos >= 0 ? vb4[i] : z; } }
        __syncthreads();
        const int hq = kvh * 8 + wave; const float sink2 = a.sinks[j * 64 + hq] * 1.4426950408889634f;
        bf16x8 qn[2];
#pragma unroll
        for (int ks = 0; ks < 2; ++ks) qn[ks] = *(const bf16x8*)(QKV + (size_t)(b * SEQ + n * 128 + fr) * QKVN + hq * 64 + 32 * ks + 8 * fq);
        for (int r = 0; r < 8; ++r) {
            const int tok = b * SEQ + n * 128 + 16 * r + fr;
            bf16x8 qf[2];
#pragma unroll
            for (int ks = 0; ks < 2; ++ks) qf[ks] = qn[ks];
            if (r < 7) {
#pragma unroll
                for (int ks = 0; ks < 2; ++ks) qn[ks] = *(const bf16x8*)(QKV + (size_t)(tok + 16) * QKVN + hq * 64 + 32 * ks + 8 * fq); }
            f32x4 st[9];
#pragma unroll
            for (int kk = 0; kk < 9; ++kk) { f32x4 acc = zero4();
#pragma unroll
                for (int ks = 0; ks < 2; ++ks) { const bf16x8 kf = *(const LAS bf16x8*)(Kl + (16 * (r + kk) + fr) * 144 + (32 * ks + 8 * fq) * 2); acc = __builtin_amdgcn_mfma_f32_16x16x32_bf16(kf, qf[ks], acc, 0, 0, 0); }
                st[kk] = acc; }
            float mx = sink2;
#pragma unroll
            for (int kk = 0; kk < 9; ++kk)
#pragma unroll
                for (int ii = 0; ii < 4; ++ii) { const int jj = 4 * fq + ii; bool vis = true;
                    if (kk == 0) vis = jj > fr; if (kk == 8) vis = jj <= fr; if (n == 0 && (r + kk) < 8) vis = false;
                    const float tv = vis ? st[kk][ii] * SC : -1.0e30f; st[kk][ii] = tv; mx = fmaxf(mx, tv); }
            mx = fmaxf(mx, shx(mx, 16, lane)); mx = fmaxf(mx, shx(mx, 32, lane));
            float l = 0.f;
#pragma unroll
            for (int kk = 0; kk < 9; ++kk)
#pragma unroll
                for (int ii = 0; ii < 4; ++ii) { const float p = fast_exp2(st[kk][ii] - mx); st[kk][ii] = p; l += p; }
            l += shx(l, 16, lane); l += shx(l, 32, lane); l += fast_exp2(sink2 - mx);
            const float inv = 1.0f / l;
            f32x4 oacc[4];
            const unsigned vrow = vbase + (16 * r + 4 * fq + q4) * 144 + 8 * p4;
#pragma unroll
            for (int cc = 0; cc < 4; ++cc) oacc[cc] = zero4();
#define ATT_PV(S, K0, K1, HASK1) { u32x4 pw; pw.x = cvt_pk_bf16(st[K0][0], st[K0][1]); pw.y = cvt_pk_bf16(st[K0][2], st[K0][3]); \
                if (HASK1) { pw.z = cvt_pk_bf16(st[K1][0], st[K1][1]); pw.w = cvt_pk_bf16(st[K1][2], st[K1][3]); } else { pw.z = 0u; pw.w = 0u; } \
                const bf16x8 pf = __builtin_bit_cast(bf16x8, pw); s16x4 lo[4], hi[4]; \
                tr_read8<16 * 144 * (K0), 16 * 144 * (K1)>(vrow, lo, hi); \
                _Pragma("unroll") for (int cc = 0; cc < 4; ++cc) oacc[cc] = __builtin_amdgcn_mfma_f32_16x16x32_bf16(cat4(lo[cc], hi[cc]), pf, oacc[cc], 0, 0, 0); }
            ATT_PV(0, 0, 1, true) ATT_PV(1, 2, 3, true) ATT_PV(2, 4, 5, true) ATT_PV(3, 6, 7, true) ATT_PV(4, 8, 8, false)
#undef ATT_PV
#pragma unroll
            for (int cc = 0; cc < 4; ++cc) { const f32x4 o = oacc[cc] * inv; u32x2 w; w.x = cvt_pk_bf16(o[0], o[1]); w.y = cvt_pk_bf16(o[2], o[3]);
                *(u32x2*)(O + (size_t)tok * D + hq * 64 + 16 * cc + 4 * fq) = w; }
        }
    }
}

__device__ __forceinline__ void phase_ret(CArgs& a, LAS unsigned char* lds, int G, int c, int wv) {
    const int tid = opaque_tid(wv), lane = tid & 63, w = __builtin_amdgcn_readfirstlane(tid >> 6), fr = lane & 15, fq = lane >> 4, q4 = (lane & 15) >> 2, p4 = lane & 3;
    const bf16_t* QR = (const bf16_t*)(a.ws + WS_ACT + ACT_QR); const bf16_t* KR = (const bf16_t*)(a.ws + WS_ACT + ACT_KR); const bf16_t* VV = (const bf16_t*)(a.ws + WS_ACT + ACT_VV);
    bf16_t* OR = (bf16_t*)(a.ws + WS_ACT + ACT_OR); float* SPp = (float*)(a.ws + WS_SP);
    constexpr int KP = 528, VP = 144;
    LAS unsigned char* Kl = lds; LAS unsigned char* Vl = lds + 128 * KP; LAS unsigned char* Vzl = Vl + 128 * VP; LAS unsigned char* Rl = Vzl + 128 * VP;
    const unsigned vb0 = (unsigned)(uintptr_t)Vl + (4 * fq + q4) * VP + 8 * p4;
    const unsigned kb0 = (unsigned)(uintptr_t)Kl + (8 * fq + q4) * KP + 64 * w + 8 * p4, vzb0 = (unsigned)(uintptr_t)Vzl + (8 * fq + q4) * VP + 8 * p4;
    const unsigned koff = (unsigned)(((tid >> 5) * D + (tid & 31) * 8) * 2);
    const unsigned voff = (unsigned)(((tid >> 3) * RVW + (tid & 7) * 8) * 2);
    const unsigned qoff = (unsigned)(((16 * w + fr) * D + 8 * fq) * 2);
    for (int uidx = (G == 256) ? ((c & 7) * 32 + (c >> 3)) : c; uidx < 256; uidx += G) {
        const int b = uidx >> 7, h = (uidx >> 3) & 15, sl = uidx & 7;
        float l2g; { const double xg = 1.0 / (double)(1 << (5 + h)); double s = 0.0, p = xg; for (int k = 1; k <= 12; ++k) { s += p / k; p *= xg; } l2g = (float)(-s * 1.4426950408889634); }
        const float dchunk = fast_exp2(128.0f * l2g);
        f32x4 racc[2][4];
#pragma unroll
        for (int d = 0; d < 2; ++d)
#pragma unroll
            for (int cv = 0; cv < 4; ++cv) racc[d][cv] = zero4();
        __syncthreads();
        u32x4 kreg[8]; bf16x8 qf[8];
        { const char* kb = (const char*)(KR + (size_t)(b * SEQ) * D + h * 256); const char* qb = (const char*)(QR + (size_t)(b * SEQ) * D + h * 256);
#pragma unroll
          for (int i = 0; i < 8; ++i) kreg[i] = *(const u32x4*)(kb + (size_t)i * 16 * D * 2 + koff);
#pragma unroll
          for (int ks = 0; ks < 8; ++ks) qf[ks] = *(const bf16x8*)(qb + ks * 64 + qoff); }
        for (int nc = 0; nc < 32; ++nc) {
            const int t0 = b * SEQ + nc * 128;
#pragma unroll
            for (int d = 0; d < 2; ++d)
#pragma unroll
                for (int cv = 0; cv < 4; ++cv) { u32x2 wv; wv.x = cvt_pk_bf16(racc[d][cv][0], racc[d][cv][1]); wv.y = cvt_pk_bf16(racc[d][cv][2], racc[d][cv][3]);
                    *(LAS u32x2*)(Rl + (16 * cv + fr) * KP + (32 * w + 16 * d + 4 * fq) * 2) = wv; }
#pragma unroll
            for (int i = 0; i < 8; ++i) { const int id = tid + 512 * i, row = id >> 5, ch = id & 31; *(LAS u32x4*)(Kl + row * KP + ch * 16) = kreg[i]; }
#pragma unroll
            for (int i = 0; i < 2; ++i) { const int id = tid + 512 * i, row = id >> 3, ch = id & 7;
                const u32x4 vv = *(const u32x4*)((const char*)(VV + (size_t)t0 * RVW + h * 512 + sl * 64) + (size_t)i * 64 * RVW * 2 + voff); const float zt = fast_exp2((float)(127 - row) * l2g);
                u32x4 vz; vz.x = cvt_pk_bf16(bf_lo(vv.x) * zt, bf_hi(vv.x) * zt); vz.y = cvt_pk_bf16(bf_lo(vv.y) * zt, bf_hi(vv.y) * zt); vz.z = cvt_pk_bf16(bf_lo(vv.z) * zt, bf_hi(vv.z) * zt); vz.w = cvt_pk_bf16(bf_lo(vv.w) * zt, bf_hi(vv.w) * zt);
                *(LAS u32x4*)(Vl + row * VP + ch * 16) = vv; *(LAS u32x4*)(Vzl + row * VP + ch * 16) = vz; }
            const int tokq = t0 + 16 * w + fr;
            __syncthreads();
            if (nc + 1 < 32) { const char* kb = (const char*)(KR + (size_t)(t0 + 128) * D + h * 256);
#pragma unroll
                for (int i = 0; i < 8; ++i) kreg[i] = *(const u32x4*)(kb + (size_t)i * 16 * D * 2 + koff); }
            f32x4 oi[4];
#pragma unroll
            for (int cv = 0; cv < 4; ++cv) oi[cv] = zero4();
            if (nc > 0) {
                bf16x8 rA[4], rB[4];
#define RET_RLD(r, ks) { _Pragma("unroll") for (int cv = 0; cv < 4; ++cv) r[cv] = *(const LAS bf16x8*)(Rl + (16 * cv + fr) * KP + (32 * (ks) + 8 * fq) * 2); }
#define RET_RMM(r, ks) { _Pragma("unroll") for (int cv = 0; cv < 4; ++cv) oi[cv] = __builtin_amdgcn_mfma_f32_16x16x32_bf16(r[cv], qf[ks], oi[cv], 0, 0, 0); }
                RET_RLD(rA, 0) __builtin_amdgcn_sched_barrier(0);
                RET_RLD(rB, 1) __builtin_amdgcn_sched_barrier(0); RET_RMM(rA, 0) __builtin_amdgcn_sched_barrier(0);
                RET_RLD(rA, 2) __builtin_amdgcn_sched_barrier(0); RET_RMM(rB, 1) __builtin_amdgcn_sched_barrier(0);
                RET_RLD(rB, 3) __builtin_amdgcn_sched_barrier(0); RET_RMM(rA, 2) __builtin_amdgcn_sched_barrier(0);
                RET_RLD(rA, 4) __builtin_amdgcn_sched_barrier(0); RET_RMM(rB, 3) __builtin_amdgcn_sched_barrier(0);
                RET_RLD(rB, 5) __builtin_amdgcn_sched_barrier(0); RET_RMM(rA, 4) __builtin_amdgcn_sched_barrier(0);
                RET_RLD(rA, 6) __builtin_amdgcn_sched_barrier(0); RET_RMM(rB, 5) __builtin_amdgcn_sched_barrier(0);
                RET_RLD(rB, 7) __builtin_amdgcn_sched_barrier(0); RET_RMM(rA, 6) __builtin_amdgcn_sched_barrier(0);
                RET_RMM(rB, 7) __builtin_amdgcn_sched_barrier(0);
#undef RET_RLD
#undef RET_RMM
                const float xi = fast_exp2((float)(16 * w + fr + 1) * l2g);
#pragma unroll
                for (int cv = 0; cv < 4; ++cv) oi[cv] = oi[cv] * xi;
            }
            float dbase[4]; { float l2o = l2g; OPAQUE_V(l2o);
#pragma unroll
              for (int ii = 0; ii < 4; ++ii) dbase[ii] = fast_exp2((float)(fr - 4 * fq - ii) * l2o); }
#define RET_AB(S) if (2 * (S) <= w) { f32x4 st[2]; st[0] = zero4(); st[1] = zero4(); const bool two = 2 * (S) + 1 <= w; \
                { bf16x8 k0[4], k1[4];     \
                  _Pragma("unroll") for (int hk = 0; hk < 2; ++hk) { \
                  _Pragma("unroll") for (int ks = 0; ks < 4; ++ks) k0[ks] = *(const LAS bf16x8*)(Kl + (16 * (2 * (S)) + fr) * KP + (32 * (4 * hk + ks) + 8 * fq) * 2); \
                  _Pragma("unroll") for (int ks = 0; ks < 4; ++ks) k1[ks] = *(const LAS bf16x8*)(Kl + (16 * (two ? 2 * (S) + 1 : 2 * (S)) + fr) * KP + (32 * (4 * hk + ks) + 8 * fq) * 2); \
                  __builtin_amdgcn_sched_barrier(0); \
                  _Pragma("unroll") for (int ks = 0; ks < 4; ++ks) { st[0] = __builtin_amdgcn_mfma_f32_16x16x32_bf16(k0[ks], qf[4 * hk + ks], st[0], 0, 0, 0); st[1] = __builtin_amdgcn_mfma_f32_16x16x32_bf16(k1[ks], qf[4 * hk + ks], st[1], 0, 0, 0); } \
                  __builtin_amdgcn_sched_barrier(0); } } \
                _Pragma("unroll") for (int hb = 0; hb < 2; ++hb) { const int kb = 2 * (S) + hb; \
                    if (kb <= w) { const float bfac = fast_exp2((float)(16 * (w - kb)) * l2g); \
                        _Pragma("unroll") for (int ii = 0; ii < 4; ++ii) { const float f = dbase[ii] * bfac; st[hb][ii] = (kb < w || fr - 4 * fq - ii >= 0) ? st[hb][ii] * f : 0.f; } } \
                    else st[hb] = zero4(); } \
                u32x4 pw; pw.x = cvt_pk_bf16(st[0][0], st[0][1]); pw.y = cvt_pk_bf16(st[0][2], st[0][3]); pw.z = cvt_pk_bf16(st[1][0], st[1][1]); pw.w = cvt_pk_bf16(st[1][2], st[1][3]); \
                const bf16x8 pf = __builtin_bit_cast(bf16x8, pw); s16x4 lo[4], hi[4]; \
                tr_read8<32 * VP * (S), 32 * VP * (S) + 16 * VP>(vb0, lo, hi); \
                _Pragma("unroll") for (int cv = 0; cv < 4; ++cv) oi[cv] = __builtin_amdgcn_mfma_f32_16x16x32_bf16(cat4(lo[cv], hi[cv]), pf, oi[cv], 0, 0, 0); }
            RET_AB(0) RET_AB(1) RET_AB(2) RET_AB(3)
#undef RET_AB
            { float s1 = 0.f, s2 = 0.f;
#pragma unroll
              for (int cv = 0; cv < 4; ++cv) { s1 += (oi[cv][0] + oi[cv][1]) + (oi[cv][2] + oi[cv][3]); s2 += (oi[cv][0] * oi[cv][0] + oi[cv][1] * oi[cv][1]) + (oi[cv][2] * oi[cv][2] + oi[cv][3] * oi[cv][3]); }
              s1 += shx(s1, 16, lane); s1 += shx(s1, 32, lane); s2 += shx(s2, 16, lane); s2 += shx(s2, 32, lane);
              if (fq == 0) *(f32x2*)(SPp + ((size_t)(tokq * 16 + h) * 8 + sl) * 2) = (f32x2){s1, s2};
#pragma unroll
              for (int cv = 0; cv < 4; ++cv) { const f32x4 o = oi[cv]; u32x2 wv; wv.x = cvt_pk_bf16(o[0], o[1]); wv.y = cvt_pk_bf16(o[2], o[3]);
                  *(u32x2*)(OR + (size_t)tokq * RVW + h * 512 + sl * 64 + 16 * cv + 4 * fq) = wv; } }
            if (nc + 1 < 32) {
                { const char* qb = (const char*)(QR + (size_t)(t0 + 128) * D + h * 256);
#pragma unroll
                  for (int ks = 0; ks < 8; ++ks) qf[ks] = *(const bf16x8*)(qb + ks * 64 + qoff); } }
#pragma unroll
            for (int d = 0; d < 2; ++d)
#pragma unroll
                for (int cv = 0; cv < 4; ++cv) racc[d][cv] = racc[d][cv] * dchunk;
#define RET_C(S) { s16x4 klo[2], khi[2], vlo[4], vhi[4]; \
                tr_read2<32 * KP * (S), 32 * KP * (S) + 4 * KP>(kb0, klo[0], khi[0]); tr_read2<32 * KP * (S) + 32, 32 * KP * (S) + 4 * KP + 32>(kb0, klo[1], khi[1]); \
                tr_read8<32 * VP * (S), 32 * VP * (S) + 4 * VP>(vzb0, vlo, vhi); \
                _Pragma("unroll") for (int d = 0; d < 2; ++d) _Pragma("unroll") for (int cv = 0; cv < 4; ++cv) \
                    racc[d][cv] = __builtin_amdgcn_mfma_f32_16x16x32_bf16(cat4(klo[d], khi[d]), cat4(vlo[cv], vhi[cv]), racc[d][cv], 0, 0, 0); }
            RET_C(0) RET_C(1) RET_C(2) RET_C(3)
#undef RET_C
            __syncthreads();
        }
    }
}
__device__ __forceinline__ void phase_gn(CArgs& a, LAS unsigned char* lds, int j, int G, int c, int wv, bool dry) {
    const int tid = opaque_tid(wv), lane = tid & 63, wave = tid >> 6;
    bf16_t* OR = (bf16_t*)(a.ws + WS_ACT + ACT_OR); const bf16_t* SG = (const bf16_t*)(a.ws + WS_ACT + ACT_SG); const float* gng = a.gn_gain + (size_t)j * RVW;
    LAS float* TL = (LAS float*)lds;
    for (int i = tid; i < RVW / 4; i += 512) *(LAS f32x4*)(TL + 4 * i) = *(const f32x4*)(gng + 4 * i);
    __syncthreads();
    for (int row = c * 8 + wave; row < T; row += G * 8) {
        unsigned go = (unsigned)(uintptr_t)TL; OPAQUE_S(go); const LAS float* gl = (const LAS float*)(uintptr_t)go;
#pragma unroll 8
        for (int hh = 0; hh < 16; ++hh) { const size_t off = (size_t)row * RVW + 512 * hh + 8 * lane;
            const u32x4 ov = *(const u32x4*)(OR + off); const u32x4 gv = *(const u32x4*)(SG + off);
            float v[8] = {bf_lo(ov.x), bf_hi(ov.x), bf_lo(ov.y), bf_hi(ov.y), bf_lo(ov.z), bf_hi(ov.z), bf_lo(ov.w), bf_hi(ov.w)};
            const float g[8] = {bf_lo(gv.x), bf_hi(gv.x), bf_lo(gv.y), bf_hi(gv.y), bf_lo(gv.z), bf_hi(gv.z), bf_lo(gv.w), bf_hi(gv.w)};
            float s = 0.f;
#pragma unroll
            for (int k = 0; k < 8; ++k) s += v[k];
            const float mu = wave_sum(s, lane) * (1.0f / 512.0f); float q = 0.f;
#pragma unroll
            for (int k = 0; k < 8; ++k) { v[k] -= mu; q += v[k] * v[k]; }
            const float rstd = 1.0f / sqrtf(wave_sum(q, lane) * (1.0f / 512.0f) + GN_EPS);
            const f32x4 ga = *(const LAS f32x4*)(gl + 512 * hh + 8 * lane), gb = *(const LAS f32x4*)(gl + 512 * hh + 8 * lane + 4);
            const float gn[8] = {ga[0], ga[1], ga[2], ga[3], gb[0], gb[1], gb[2], gb[3]};
            float o[8];
#pragma unroll
            for (int k = 0; k < 8; ++k) o[k] = g[k] * (v[k] * rstd * gn[k]);
            u32x4 wv; wv.x = cvt_pk_bf16(o[0], o[1]); wv.y = cvt_pk_bf16(o[2], o[3]); wv.z = cvt_pk_bf16(o[4], o[5]); wv.w = cvt_pk_bf16(o[6], o[7]);
            *(u32x4*)((dry ? (bf16_t*)(a.ws + WS_Z) : OR) + off) = wv; }
    }
}

constexpr int NPHASE = 3 + 9 * NLAYER;
__device__ __forceinline__ CArgs& fresh_args() { CArgs* p = (CArgs*)__builtin_amdgcn_kernarg_segment_ptr(); OPAQUE_S(p); return *p; }
__global__ void __launch_bounds__(512, 2) mk_fwd(Args a_byval) {
    extern __shared__ __attribute__((aligned(16))) unsigned char lds_raw[];
    LAS unsigned char* lds = (LAS unsigned char*)lds_raw;
    const int G = gridDim.x, c = blockIdx.x;
    const int wv = __builtin_amdgcn_readfirstlane((int)threadIdx.x >> 6);
    { const int tid = opaque_tid(wv); for (int i = tid; i < (LDS_BYTES - LDSCTL_OFF) / 4; i += 512) ((LAS unsigned*)(lds + LDSCTL_OFF))[i] = 0u; }
    __syncthreads();
    { CArgs& a = fresh_args(); if (a.use_bar) { const int tid = opaque_tid(wv); if (tid == 0) (void)xb_add((unsigned*)(a.ws + WS_CTL) + CW_BAR + XB_XCNT(xb_xcc_id()), 1u); } }
    int lo, hi; { CArgs& a = fresh_args(); lo = a.ph_lo; hi = a.ph_hi; }
#ifndef SELMASK
#define SELMASK 0xffffffffu
#endif
#define SEL(b) (((SELMASK) >> (b)) & 1u)
#ifndef REP_BIT
#define REP_BIT 31
#endif
#ifndef REP_N
#define REP_N 1
#endif
#define NREP(b) (((b) == REP_BIT) ? REP_N : 1)
#define IN(k) (lo <= (k) && (k) < hi)
#define SEAM(k) do { if (IN(k) && IN((k) + 1)) { CArgs& ab = fresh_args(); XcdBarrier b2; b2.bar = (unsigned*)(ab.ws + WS_CTL) + CW_BAR; b2.x = xb_xcc_id(); b2.st = (volatile LAS unsigned*)(lds + LDSCTL_OFF + 512); xcd_barrier(b2, opaque_tid(wv)); } } while (0)
    for (int rp_ = 0; rp_ < NREP(0); ++rp_) { if (SEL(0) && IN(0)) { phase_prep(fresh_args(), lds, G, c, wv); } SEAM(0); }
    if (SEL(1) && IN(1)) { phase_modreduce(fresh_args(), G, c, wv); } SEAM(1);
    for (int rp_ = 0; rp_ < NREP(2); ++rp_) { if (SEL(2) && IN(2)) { phase_u0(fresh_args(), lds, G, c, wv); } SEAM(2); }
    for (int layer = 0; layer < NLAYER; ++layer) {
        const int pb = 3 + 9 * layer, j = layer >> 1;
        if ((layer & 1) == 0) {
            for (int rp_ = 0; rp_ < NREP(3); ++rp_) { if (SEL(3) && IN(pb + 0)) { CArgs& a = fresh_args(); unsigned char* ws = a.ws; pg8::StaticOrder S; S.init((const bf16_t*)(ws + WS_U), (const bf16_t*)(ws + WS_W + W_QKV) + (size_t)j * QKVN * D, T, QKVN, D, G, c);
                pg8::EpiQKV E{(bf16_t*)(ws + WS_ACT + ACT_QKV), (const float*)(ws + WS_BQKV) + j * QKVN, (const float*)(ws + WS_CSA), (const float*)(ws + WS_CSA) + T * 8};
                pg8::gemm_phase<pg8::EpiQKV, pg8::StaticOrder, false>(lds, D, S, E, wv);
                { const int idle0 = S.nwg % G;
                  if (idle0 > 0 && c >= idle0) { const int tid = opaque_tid(wv); prep_items(fresh_args(), lds, __builtin_amdgcn_readfirstlane(tid >> 6), tid & 63, (c - idle0) * 8 + __builtin_amdgcn_readfirstlane(tid >> 6), (G - idle0) * 8, 1 + (layer >> 1)); __syncthreads(); } } } SEAM(pb + 0); }
            for (int rp_ = 0; rp_ < NREP(4); ++rp_) { if (SEL(4) && IN(pb + 1)) { phase_attn(fresh_args(), lds, j, G, c, wv); } SEAM(pb + 1); }
        } else {
            for (int rp_ = 0; rp_ < NREP(5); ++rp_) { if (SEL(5) && IN(pb + 0)) { CArgs& a = fresh_args(); unsigned char* ws = a.ws; pg8::StaticOrder S; S.init((const bf16_t*)(ws + WS_U), (const bf16_t*)(ws + WS_W + W_RET) + (size_t)j * RETN * D, T, RET_QKV, D, G, c);
                pg8::EpiRet E{(bf16_t*)(ws + WS_ACT + ACT_QR), (bf16_t*)(ws + WS_ACT + ACT_KR), (bf16_t*)(ws + WS_ACT + ACT_VV), (const float*)(ws + WS_CSR)};
                pg8::gemm_phase<pg8::EpiRet, pg8::StaticOrder, false>(lds, D, S, E, wv); } SEAM(pb + 0); }
            for (int rp_ = 0; rp_ < NREP(6); ++rp_) { if (SEL(6) && IN(pb + 1)) { phase_ret(fresh_args(), lds, G, c, wv); } SEAM(pb + 1); }
            for (int rp_ = NREP(7) - 1; rp_ >= 0; --rp_) { if (SEL(7) && IN(pb + 2)) { CArgs& a = fresh_args(); unsigned char* ws = a.ws; pg8::StaticOrder S; S.init((const bf16_t*)(ws + WS_U), (const bf16_t*)(ws + WS_W + W_RET) + ((size_t)j * RETN + RET_QKV) * D, T, RVW, D, G, c);
                pg8::EpiG E{(bf16_t*)(ws + WS_ACT + ACT_OR), (const float*)(ws + WS_SP), a.gn_gain + (size_t)j * RVW, (LAS float*)(lds + LDS_GNST), (bf16_t*)(ws + WS_ACT + (rp_ > 0 ? ACT_SG : ACT_OR))};
                pg8::gemm_phase<pg8::EpiG, pg8::StaticOrder, false>(lds, D, S, E, wv); } SEAM(pb + 2); }
        }
        for (int rp_ = 0; rp_ < NREP(8); ++rp_) { if (SEL(8) && IN(pb + 3)) { CArgs& a = fresh_args(); unsigned char* ws = a.ws; const bool at = (layer & 1) == 0; const int K = at ? D : RVW;
            pg8::StaticOrder S; S.init(at ? (const bf16_t*)(ws + WS_ACT + ACT_O) : (const bf16_t*)(ws + WS_ACT + ACT_OR), at ? (const bf16_t*)(ws + WS_W + W_OA) + (size_t)j * D * D : (const bf16_t*)(ws + WS_W + W_OR) + (size_t)j * D * RVW, T, D, K, G, c);
            pg8::EpiZ E{(bf16_t*)(ws + WS_Z), at ? a.b_oa + (size_t)j * D : nullptr, (const float*)(ws + WS_MODL) + (size_t)layer * 2 * 24576 + 2 * D};
            pg8::gemm_phase<pg8::EpiZ, pg8::StaticOrder, false>(lds, K, S, E, wv); } SEAM(pb + 3); }
        for (int rp_ = NREP(9) - 1; rp_ >= 0; --rp_) { if (SEL(9) && IN(pb + 4)) { phase_ln1(fresh_args(), lds, layer, G, c, wv, rp_ > 0); } SEAM(pb + 4); }
        for (int rp_ = 0; rp_ < NREP(10); ++rp_)
        for (int st = 0; st < 3; ++st) { const int ph = pb + 5 + st;
            if (IN(ph)) { CArgs& a = fresh_args(); unsigned char* ws = a.ws; const int ntile = moe_tables(a, lds, layer, wv, st > 0 && lo < ph);
                const int cx = (G == 256) ? ((c & 7) * 32 + (c >> 3)) : c;
                const int Ub = 2 * ntile, R1 = (Ub >= G ? (Ub / G) * G : Ub) & ~1, nlate = Ub - R1, Dm = (R1 >> 1) * 16;
                if (SEL(10) && (st == 0 || (st == 1 && cx < nlate))) {
                    pg8::GuOrder S{G, cx, st == 0 ? 0 : R1, st == 0 ? R1 : Ub, (const LAS int*)(lds + LDSCTL_OFF), (const LAS int*)(lds + LDSCTL_OFF) + 64, (const int*)(ws + WS_ROWS), (const bf16_t*)(ws + WS_U), (const bf16_t*)(ws + WS_W + W_GU) + (size_t)layer * NEXP * GUW * D};
                    pg8::EpiGU E{(bf16_t*)(ws + WS_ACT + ACT_H), a.b_gu + (size_t)layer * NEXP * GUW};
                    pg8::gemm_phase<pg8::EpiGU, pg8::GuOrder, true>(lds, D, S, E, wv); }
                if (SEL(11) && st >= 1) {
                    pg8::DownOrder S{G, cx, st == 1 ? 0 : Dm, st == 1 ? Dm : ntile * 16, st == 1 ? nlate : 0, (const LAS int*)(lds + LDSCTL_OFF), (const LAS int*)(lds + LDSCTL_OFF) + 64, (const bf16_t*)(ws + WS_ACT + ACT_H), (const bf16_t*)(ws + WS_W + W_DN) + (size_t)layer * NEXP * D * EFF};
                    pg8::EpiDown E{(unsigned char*)(ws + WS_ACT + ACT_YP), a.b_dn + (size_t)layer * NEXP * D};
                    pg8::gemm_phase<pg8::EpiDown, pg8::DownOrder, false>(lds, a.k_dn, S, E, wv); } }
            SEAM(ph); }
        for (int rp_ = NREP(12) - 1; rp_ >= 0; --rp_) { if (SEL(12) && IN(pb + 8)) { phase_ln2(fresh_args(), lds, layer, G, c, wv, rp_ > 0, lo < pb + 8); } SEAM(pb + 8); }
    }
#undef IN
#undef SEAM
}

extern "C" void kernel_launch(void* const* d_in, const int* in_sizes, int n_in, void* d_out, int out_size, void* d_ws, size_t ws_size, hipStream_t stream) {
    static int grid = 0;
    if (grid == 0) {
        if (n_in != 22 || ws_size < WS_END) { fprintf(stderr, "kernel_launch: unexpected n_in %d or ws_size %zu (< %zu)\n", n_in, ws_size, (size_t)WS_END); grid = -1; return; }
        int dev = 0, cus = 0, per_cu = 0;
        if (hipGetDevice(&dev) != hipSuccess || hipDeviceGetAttribute(&cus, hipDeviceAttributeMultiprocessorCount, dev) != hipSuccess) { grid = -1; return; }
        if (hipFuncSetAttribute((const void*)mk_fwd, hipFuncAttributeMaxDynamicSharedMemorySize, LDS_BYTES) != hipSuccess) { fprintf(stderr, "kernel_launch: hipFuncSetAttribute failed\n"); grid = -1; return; }
        if (hipOccupancyMaxActiveBlocksPerMultiprocessor(&per_cu, (const void*)mk_fwd, 512, LDS_BYTES) != hipSuccess || per_cu < 1) fprintf(stderr, "kernel_launch: occupancy query reports %d\n", per_cu);
        (void)hipGetLastError();
        grid = cus;
    }
    if (grid < 0) return;
    (void)hipMemsetAsync((char*)d_ws + WS_CTL, 0, CTL_BYTES, stream);
    Args a{};
    a.x = (const float*)d_in[0]; a.c = (const float*)d_in[1]; a.pos = (const int*)d_in[2]; a.mod_w = (const float*)d_in[3]; a.mod_b = (const float*)d_in[4]; a.mod_layer = (const float*)d_in[5];
    a.ln_gain = (const float*)d_in[6]; a.ln_bias = (const float*)d_in[7]; a.w_qkv = (const float*)d_in[8]; a.b_qkv = (const float*)d_in[9]; a.sinks = (const float*)d_in[10];
    a.w_oa = (const float*)d_in[11]; a.b_oa = (const float*)d_in[12]; a.w_ret = (const float*)d_in[13]; a.gn_gain = (const float*)d_in[14]; a.w_or = (const float*)d_in[15];
    a.router_w = (const float*)d_in[16]; a.router_b = (const float*)d_in[17]; a.w_gu = (const float*)d_in[18]; a.b_gu = (const float*)d_in[19]; a.w_dn = (const float*)d_in[20]; a.b_dn = (const float*)d_in[21];
    a.out = (float*)d_out; a.ws = (unsigned char*)d_ws; a.k_dn = EFF;
#if MK_ONE_LAUNCH
    a.ph_lo = 0; a.ph_hi = NPHASE; a.use_bar = 1;
    hipLaunchKernelGGL(mk_fwd, dim3(grid), dim3(512), LDS_BYTES, stream, a);
#else
    a.use_bar = 0;
    for (int p = 0; p < NPHASE; ++p) { if (p >= 3 && (((p - 3) / 9) & 1) == 0 && ((p - 3) % 9) == 2) continue;
        a.ph_lo = p; a.ph_hi = p + 1; hipLaunchKernelGGL(mk_fwd, dim3(grid), dim3(512), LDS_BYTES, stream, a); }
#endif
}
```
